# Optimizing an MI355X kernel written in HIP

```python
import jax, jax.numpy as jnp
from jax import lax
import numpy as np

D_MODEL = 2048
BATCH = 4
SEQ = 2048
DEPTH = 1
DEC_BATCH = 128
DEC_SEQ = 1
PAST_LEN = 16384
PAGE_SIZE = 128

N_MEM = 256
CONV_WIDTH = 1024
CONV_K = 3
RNN_WIDTH = 1024
RNN_HEADS = 8
RNN_HEAD_DIM = RNN_WIDTH // RNN_HEADS
RNN_CONV_K = 4
RG_C = 8.0
ATTN_HEADS = 4
ATTN_HEAD_DIM = 256
ATTN_WIDTH = ATTN_HEADS * ATTN_HEAD_DIM
N_BRANCH = 3
IN_SIZES = (CONV_WIDTH, CONV_WIDTH, CONV_WIDTH, RNN_WIDTH, RNN_WIDTH, ATTN_WIDTH, N_BRANCH * D_MODEL)
IN_SPLITS = tuple(int(s) for s in np.cumsum(IN_SIZES)[:-1])
IN_WIDTH = int(sum(IN_SIZES))
PEER_HEADS = 8
PEER_NKEYS = 128
PEER_EXPERTS = PEER_NKEYS * PEER_NKEYS
PEER_TOPK = 16
PEER_QDIM = 256
PEER_HALF = PEER_QDIM // 2
PEER_BLOCK = 128
DN_ALPHA = (2.0 * DEPTH) ** 0.25
DN_BETA = (8.0 * DEPTH) ** -0.25
LN_EPS = 1e-5

kernel_name = "hybrid_conv_rglru_mem_peer_step"


def layernorm(x, g, b):
    xf = x.astype(jnp.float32)
    mu = jnp.mean(xf, axis=-1, keepdims=True)
    var = jnp.mean(jnp.square(xf - mu), axis=-1, keepdims=True)
    return ((xf - mu) * lax.rsqrt(var + LN_EPS) * g.astype(jnp.float32) + b.astype(jnp.float32)).astype(x.dtype)


def causal_dwconv(buf, x, w):
    xp = jnp.concatenate([buf.astype(x.dtype), x], axis=1)
    k_w = w.shape[0]
    s = x.shape[1]
    y = sum(xp[:, k:k + s] * w[k] for k in range(k_w))
    return y, xp[:, xp.shape[1] - (k_w - 1):]


def rg_lru(xr, h0, wa, ba, wx, bx, lam):
    bn, s, _ = xr.shape
    xh = xr.reshape(bn, s, RNN_HEADS, RNN_HEAD_DIM)
    r = jax.nn.sigmoid(jnp.einsum('bshi,hij->bshj', xh, wa).reshape(bn, s, RNN_WIDTH) + ba)
    i = jax.nn.sigmoid(jnp.einsum('bshi,hij->bshj', xh, wx).reshape(bn, s, RNN_WIDTH) + bx)
    log_a = -RG_C * r.astype(jnp.float32) * jax.nn.softplus(-lam.astype(jnp.float32))
    a = jnp.exp(log_a)
    u = jnp.sqrt(-jnp.expm1(2.0 * log_a)) * (i * xr).astype(jnp.float32)

    def step(h, au):
        a_t, u_t = au
        h = a_t * h + u_t
        return h, h

    h_last, hs = lax.scan(step, h0.astype(jnp.float32), (jnp.swapaxes(a, 0, 1), jnp.swapaxes(u, 0, 1)))
    return jnp.swapaxes(hs, 0, 1).astype(xr.dtype), h_last.astype(h0.dtype)


def mem_attention(q, mem_k, mem_v):
    bn, s, _ = q.shape
    qh = q.reshape(bn, s, ATTN_HEADS, ATTN_HEAD_DIM)
    sc = jnp.einsum('bqhd,bkhd->bhqk', qh, mem_k.astype(q.dtype)).astype(jnp.float32) * (ATTN_HEAD_DIM ** -0.5)
    p = jax.nn.softmax(sc, axis=-1)
    o = jnp.einsum('bhqk,bkhd->bqhd', p.astype(q.dtype), mem_v.astype(q.dtype))
    return o.reshape(bn, s, ATTN_WIDTH)


def mixer_sublayer(x, mem_k, mem_v, conv_buf, rg_buf, rg_h,
                   w_in, conv_w, rg_conv_w, rg_conv_b, rg_wa, rg_ba, rg_wx, rg_bx, rg_lambda,
                   w_br_conv, w_br_rnn, w_br_attn, w_o):
    bn, s, _ = x.shape
    z = x @ w_in
    cb, cc, cx, rx, rgate, q, g = jnp.split(z, IN_SPLITS, axis=-1)
    conv_y, conv_buf_new = causal_dwconv(conv_buf, cc * cx, conv_w)
    y_conv = cb * conv_y
    xr, rg_buf_new = causal_dwconv(rg_buf, rx, rg_conv_w)
    xr = xr + rg_conv_b
    h_seq, h_new = rg_lru(xr, rg_h, rg_wa, rg_ba, rg_wx, rg_bx, rg_lambda)
    y_rnn = h_seq * jax.nn.gelu(rgate)
    y_att = mem_attention(q, mem_k, mem_v)
    gates = jax.nn.sigmoid(g.reshape(bn, s, N_BRANCH, D_MODEL))
    merged = (gates[:, :, 0] * (y_conv @ w_br_conv)
              + gates[:, :, 1] * (y_rnn @ w_br_rnn)
              + gates[:, :, 2] * (y_att @ w_br_attn))
    return merged @ w_o, conv_buf_new, rg_buf_new, h_new


def peer_block(xb, wq, keys, u_tab, v_tab):
    t = xb.shape[0]
    q = (xb @ wq).reshape(t, PEER_HEADS, 2, PEER_HALF)
    sc = jnp.einsum('thcd,hckd->thck', q, keys)
    s1, i1 = lax.top_k(sc[:, :, 0], PEER_TOPK)
    s2, i2 = lax.top_k(sc[:, :, 1], PEER_TOPK)
    comb = (s1[..., :, None] + s2[..., None, :]).reshape(t, PEER_HEADS, PEER_TOPK * PEER_TOPK)
    cand = (i1[..., :, None] * PEER_NKEYS + i2[..., None, :]).reshape(t, PEER_HEADS, PEER_TOPK * PEER_TOPK)
    top, pos = lax.top_k(comb, PEER_TOPK)
    e = jnp.take_along_axis(cand, pos, axis=-1)
    gw = jax.nn.softmax(top.astype(jnp.float32), axis=-1).astype(xb.dtype)
    u = jnp.take(u_tab, e, axis=0)
    act = jax.nn.gelu(jnp.einsum('thkd,td->thk', u, xb))
    v = jnp.take(v_tab, e, axis=0)
    return jnp.einsum('thk,thkd->td', gw * act, v)


def peer_ffn(x, wq, keys, u_tab, v_tab):
    shp = x.shape
    xf = x.reshape(-1, D_MODEL)
    n = xf.shape[0]
    pad = (-n) % PEER_BLOCK
    xb = jnp.pad(xf, ((0, pad), (0, 0))).reshape(-1, PEER_BLOCK, D_MODEL)
    yb = lax.map(lambda blk: peer_block(blk, wq, keys, u_tab, v_tab), xb)
    return yb.reshape(-1, D_MODEL)[:n].reshape(shp)


def setup_inputs(seed: int = 0) -> dict:
    key = jax.random.key(seed)
    ks = jax.random.split(key, 40)
    f32 = jnp.float32

    def nrm(k, shape, scale):
        return jax.random.normal(k, shape, f32) * scale

    a0 = jax.random.uniform(ks[19], (DEPTH, RNN_WIDTH), f32, minval=0.9, maxval=0.999)
    s0 = a0 ** (1.0 / RG_C)
    rg_lambda = jnp.log(s0) - jnp.log1p(-s0)
    return {
        "x_prompt": nrm(ks[0], (BATCH, SEQ, D_MODEL), 1.0),
        "x_sample": nrm(ks[1], (DEC_BATCH, DEC_SEQ, D_MODEL), 1.0),
        "mem_prompt": nrm(ks[2], (BATCH, N_MEM, D_MODEL), 1.0),
        "cache_mem_k": nrm(ks[3], (DEPTH, DEC_BATCH, N_MEM, ATTN_HEADS, ATTN_HEAD_DIM), 1.0),
        "cache_mem_v": nrm(ks[4], (DEPTH, DEC_BATCH, N_MEM, ATTN_HEADS, ATTN_HEAD_DIM), 1.0),
        "state_conv_z": nrm(ks[5], (DEPTH, DEC_BATCH, CONV_K - 1, CONV_WIDTH), 1.0),
        "state_rglru_conv": nrm(ks[6], (DEPTH, DEC_BATCH, RNN_CONV_K - 1, RNN_WIDTH), 1.0),
        "state_rglru_h": nrm(ks[7], (DEPTH, DEC_BATCH, RNN_WIDTH), 0.5),
        "w_in": nrm(ks[8], (DEPTH, D_MODEL, IN_WIDTH), D_MODEL ** -0.5),
        "conv_w": nrm(ks[9], (DEPTH, CONV_K, CONV_WIDTH), CONV_K ** -0.5),
        "rg_conv_w": nrm(ks[10], (DEPTH, RNN_CONV_K, RNN_WIDTH), RNN_CONV_K ** -0.5),
        "rg_conv_b": nrm(ks[11], (DEPTH, RNN_WIDTH), 0.01),
        "rg_wa": nrm(ks[12], (DEPTH, RNN_HEADS, RNN_HEAD_DIM, RNN_HEAD_DIM), RNN_HEAD_DIM ** -0.5),
        "rg_ba": nrm(ks[13], (DEPTH, RNN_WIDTH), 0.01),
        "rg_wx": nrm(ks[14], (DEPTH, RNN_HEADS, RNN_HEAD_DIM, RNN_HEAD_DIM), RNN_HEAD_DIM ** -0.5),
        "rg_bx": nrm(ks[15], (DEPTH, RNN_WIDTH), 0.01),
        "rg_lambda": rg_lambda,
        "w_mk": nrm(ks[16], (DEPTH, D_MODEL, ATTN_WIDTH), D_MODEL ** -0.5),
        "w_mv": nrm(ks[17], (DEPTH, D_MODEL, ATTN_WIDTH), D_MODEL ** -0.5 * DN_BETA),
        "w_br_conv": nrm(ks[18], (DEPTH, CONV_WIDTH, D_MODEL), CONV_WIDTH ** -0.5 * DN_BETA),
        "w_br_rnn": nrm(ks[20], (DEPTH, RNN_WIDTH, D_MODEL), RNN_WIDTH ** -0.5 * DN_BETA),
        "w_br_attn": nrm(ks[21], (DEPTH, ATTN_WIDTH, D_MODEL), ATTN_WIDTH ** -0.5 * DN_BETA),
        "w_o": nrm(ks[22], (DEPTH, D_MODEL, D_MODEL), D_MODEL ** -0.5 * DN_BETA),
        "ln1_g": 1.0 + nrm(ks[23], (DEPTH, D_MODEL), 0.01),
        "ln1_b": nrm(ks[24], (DEPTH, D_MODEL), 0.01),
        "peer_wq": nrm(ks[25], (DEPTH, D_MODEL, PEER_HEADS * PEER_QDIM), D_MODEL ** -0.5),
        "peer_keys": nrm(ks[26], (DEPTH, PEER_HEADS, 2, PEER_NKEYS, PEER_HALF), PEER_HALF ** -0.5),
        "peer_u": nrm(ks[27], (DEPTH, PEER_EXPERTS, D_MODEL), D_MODEL ** -0.5),
        "peer_v": nrm(ks[28], (DEPTH, PEER_EXPERTS, D_MODEL), PEER_HEADS ** -0.5 * DN_BETA),
        "ln2_g": 1.0 + nrm(ks[29], (DEPTH, D_MODEL), 0.01),
        "ln2_b": nrm(ks[30], (DEPTH, D_MODEL), 0.01),
    }


def reference(x_prompt, x_sample, mem_prompt, cache_mem_k, cache_mem_v, state_conv_z, state_rglru_conv,
              state_rglru_h, w_in, conv_w, rg_conv_w, rg_conv_b, rg_wa, rg_ba, rg_wx, rg_bx, rg_lambda,
              w_mk, w_mv, w_br_conv, w_br_rnn, w_br_attn, w_o, ln1_g, ln1_b,
              peer_wq, peer_keys, peer_u, peer_v, ln2_g, ln2_b):
    xp, xs = x_prompt, x_sample
    bp = xp.shape[0]
    dt = xp.dtype
    mk_l, mv_l, czp_l, rcp_l, hp_l, czs_l, rcs_l, hs_l = [], [], [], [], [], [], [], []
    for l in range(DEPTH):
        lp = (w_in[l], conv_w[l], rg_conv_w[l], rg_conv_b[l], rg_wa[l], rg_ba[l], rg_wx[l], rg_bx[l],
              rg_lambda[l], w_br_conv[l], w_br_rnn[l], w_br_attn[l], w_o[l])
        mk = (mem_prompt @ w_mk[l]).reshape(bp, N_MEM, ATTN_HEADS, ATTN_HEAD_DIM)
        mv = (mem_prompt @ w_mv[l]).reshape(bp, N_MEM, ATTN_HEADS, ATTN_HEAD_DIM)
        zc = jnp.zeros((bp, CONV_K - 1, CONV_WIDTH), dt)
        zr = jnp.zeros((bp, RNN_CONV_K - 1, RNN_WIDTH), dt)
        zh = jnp.zeros((bp, RNN_WIDTH), dt)
        o_p, cz_p, rc_p, h_p = mixer_sublayer(xp, mk, mv, zc, zr, zh, *lp)
        o_s, cz_s, rc_s, h_s = mixer_sublayer(xs, cache_mem_k[l], cache_mem_v[l], state_conv_z[l],
                                              state_rglru_conv[l], state_rglru_h[l], *lp)
        xp = layernorm(DN_ALPHA * xp + o_p, ln1_g[l], ln1_b[l])
        xs = layernorm(DN_ALPHA * xs + o_s, ln1_g[l], ln1_b[l])
        pp = (peer_wq[l], peer_keys[l], peer_u[l], peer_v[l])
        xp = layernorm(DN_ALPHA * xp + peer_ffn(xp, *pp), ln2_g[l], ln2_b[l])
        xs = layernorm(DN_ALPHA * xs + peer_ffn(xs, *pp), ln2_g[l], ln2_b[l])
        mk_l.append(mk); mv_l.append(mv)
        czp_l.append(cz_p); rcp_l.append(rc_p); hp_l.append(h_p)
        czs_l.append(cz_s); rcs_l.append(rc_s); hs_l.append(h_s)
    mem_k_prompt = jnp.stack(mk_l)
    mem_v_prompt = jnp.stack(mv_l)
    conv_z_prompt = jnp.stack(czp_l)
    rglru_conv_prompt = jnp.stack(rcp_l)
    rglru_h_prompt = jnp.stack(hp_l)
    conv_z_sample = jnp.stack(czs_l)
    rglru_conv_sample = jnp.stack(rcs_l)
    rglru_h_sample = jnp.stack(hs_l)
    return (xp, xs, mem_k_prompt, mem_v_prompt, conv_z_prompt, rglru_conv_prompt, rglru_h_prompt,
            conv_z_sample, rglru_conv_sample, rglru_h_sample)
```

```cpp
#define DBG_DUMP_OFF (W_YCAT + (size_t)2 * TPAD * 1024 * 2)
#define DBG_DUMP_LD 1024
#define DBG_LAST 6
#define REPMASK 0
#include <hip/hip_runtime.h>
#include <hip/hip_cooperative_groups.h>
#include <cstdio>
namespace cg = cooperative_groups;

#define LAS __attribute__((address_space(3)))
typedef unsigned short bf16_t;
typedef short bf16x8 __attribute__((ext_vector_type(8)));
typedef float f32x4 __attribute__((ext_vector_type(4)));
typedef float f32x2 __attribute__((ext_vector_type(2)));
typedef unsigned u32x4 __attribute__((ext_vector_type(4)));
typedef unsigned u32x2 __attribute__((ext_vector_type(2)));

constexpr int DM = 2048, TP = 8192, TS = 128, TT = 8320, TPAD = 8448, NMEM = 1024, INW = 12288;
constexpr int NPH = 13;
constexpr float DN_ALPHA = 1.189207115002721f;
constexpr float LN_EPS = 1e-5f;
constexpr size_t O_Y = 0, O_MK = 17039360, O_MV = 18087936, O_CZP = 19136512, O_RCP = 19144704, O_HP = 19156992,
                 O_CZS = 19161088, O_RCS = 19423232, O_HS = 19816448;
constexpr size_t al256(size_t x) { return (x + 255) & ~(size_t)255; }
constexpr size_t W_AALL = 0;
constexpr size_t W_BTALL = W_AALL + (size_t)9472 * 2048 * 2;
constexpr size_t W_WBRT = W_BTALL + (size_t)14336 * 2048 * 2;
constexpr size_t W_WOT = W_WBRT + (size_t)3 * 2048 * 1024 * 2;
constexpr size_t W_WQT = W_WOT + (size_t)2048 * 2048 * 2;
constexpr size_t W_WGT = W_WQT + (size_t)2048 * 2048 * 2;
constexpr size_t W_WKT = W_WGT + (size_t)2048 * 256 * 2;
constexpr size_t W_UB = W_WKT + (size_t)2048 * 256 * 2;
constexpr size_t W_VB = W_UB + (size_t)16384 * 2048 * 2;
constexpr size_t W_Z = W_VB + (size_t)16384 * 2048 * 2;
constexpr size_t W_MKB = W_Z + (size_t)TPAD * INW * 2;
constexpr size_t W_VTB = W_MKB + (size_t)1024 * 1024 * 2;
constexpr size_t W_YCAT = W_VTB + (size_t)1024 * 1024 * 2;
constexpr size_t W_XR = W_YCAT + (size_t)3 * TPAD * 1024 * 2;
constexpr size_t W_SA = W_XR + (size_t)TPAD * 1024 * 2;
constexpr size_t W_SU = W_SA + (size_t)TPAD * 1024 * 4;
constexpr size_t W_CHK = W_SU + (size_t)TPAD * 1024 * 4;
constexpr size_t W_MF = W_CHK + (size_t)2 * 4 * 32 * 1024 * 4;
constexpr size_t W_MB = W_MF + (size_t)TPAD * DM * 4;
constexpr size_t W_SCU = W_MB + (size_t)TPAD * DM * 2;
constexpr size_t W_SCV = W_SCU + 16384 * 4;
constexpr size_t W_BAR = W_SCV + 16384 * 4;
constexpr size_t W_END = W_BAR + 2048;
constexpr size_t W_H1 = W_Z;
constexpr size_t W_X1F = W_Z + (size_t)TPAD * DM * 4;
constexpr size_t W_X1B = W_X1F + (size_t)TPAD * DM * 4;
constexpr size_t W_QP = W_YCAT;
constexpr size_t W_SC = W_MF;
constexpr size_t W_PICKS = W_SA;
static_assert(W_X1B + (size_t)TPAD * DM * 2 <= W_MKB, "alias overflow");
static_assert((size_t)TPAD * DM * 2 <= (size_t)3 * TPAD * 1024 * 2, "alias overflow");

struct Params {
    const float* in[31];
    float* out;
    unsigned char* ws;
    int ph_lo, ph_hi;
};

typedef __bf16 bf16x2_t __attribute__((ext_vector_type(2)));
__device__ __forceinline__ unsigned cvt_pk_bf16(float lo, float hi) { const f32x2 v = {lo, hi}; return __builtin_bit_cast(unsigned, __builtin_convertvector(v, bf16x2_t)); }
__device__ __forceinline__ float bf_lo(unsigned w) { return __uint_as_float(w << 16); }
__device__ __forceinline__ float bf_hi(unsigned w) { return __uint_as_float(w & 0xffff0000u); }
__device__ __forceinline__ float bf1(bf16_t b) { return __uint_as_float(((unsigned)b) << 16); }
__device__ __forceinline__ bf16_t f2bf(float f) { return (bf16_t)(cvt_pk_bf16(f, 0.f) & 0xffffu); }
__device__ __forceinline__ void unpack8(u32x4 w, float* v) {
    v[0] = bf_lo(w.x); v[1] = bf_hi(w.x); v[2] = bf_lo(w.y); v[3] = bf_hi(w.y); v[4] = bf_lo(w.z); v[5] = bf_hi(w.z); v[6] = bf_lo(w.w); v[7] = bf_hi(w.w);
}
__device__ __forceinline__ u32x4 pack8(const float* v) {
    u32x4 w; w.x = cvt_pk_bf16(v[0], v[1]); w.y = cvt_pk_bf16(v[2], v[3]); w.z = cvt_pk_bf16(v[4], v[5]); w.w = cvt_pk_bf16(v[6], v[7]); return w;
}
__device__ __forceinline__ float fast_exp(float x) { return __builtin_amdgcn_exp2f(x * 1.4426950408889634f); }
__device__ __forceinline__ float sigmoidf_(float x) { return __builtin_amdgcn_rcpf(1.0f + fast_exp(-x)); }
__device__ __forceinline__ float gelu_tanh(float x) {
    const float z = 0.7978845608028654f * (x + 0.044715f * x * x * x);
    const float th = 1.0f - 2.0f * __builtin_amdgcn_rcpf(1.0f + fast_exp(2.0f * z));
    return 0.5f * x * (1.0f + th);
}
__device__ __forceinline__ int launder_tid() { int t = threadIdx.x; asm volatile("" : "+v"(t)); return t; }
__device__ __forceinline__ float wave_sum(float v) {
#pragma unroll
    for (int o = 32; o > 0; o >>= 1) v += __shfl_xor(v, o, 64);
    return v;
}

constexpr int BM = 256, BK = 64, HALF = 128, HTB = HALF * BK * 2, STAGE_BYTES = 8 * HTB, NXCD = 8, WGM = 8;
__device__ __forceinline__ int lds_byte(int r, int c) { const int st = (r >> 4) * 2 + (c >> 5), rr = r & 15, cc = c & 31, ob = rr * 64 + cc * 2; return st * 1024 + (ob ^ (((ob >> 9) & 1) << 5)); }
__device__ __forceinline__ void stage_rc(int b, int& R, int& C) { const int st = b / 1024, sb = b % 1024, swz = sb ^ (((sb >> 9) & 1) << 5); R = (st >> 1) * 16 + swz / 64; C = (st & 1) * 32 + (swz % 64) / 2; }
__device__ __forceinline__ int perm32(int rho) { const int n = rho >> 4, i = rho & 15; return 8 * (i >> 2) + 4 * n + (i & 3); }

struct Unit { int pm, pn, ka; };
struct Gemm { const bf16_t* A; const bf16_t* Bt; int lda, ldb, K; };

__device__ __forceinline__ void std_tile(int L, int nM, int nN, int& pm, int& pn) {
    const int nwg = nM * nN; int wgid = L;
    { const int q = nwg / NXCD, r = nwg % NXCD, xcd = wgid % NXCD, off = wgid / NXCD; wgid = (xcd < r ? xcd * (q + 1) : r * (q + 1) + (xcd - r) * q) + off; }
    const int nig = WGM * nN, gid = wgid / nig, fm = gid * WGM, gsz = (nM - fm) < WGM ? (nM - fm) : WGM;
    pm = fm + ((wgid % nig) % gsz); pn = (wgid % nig) / gsz;
}

template <class Epi, class Sched>
__device__ __forceinline__ void gemm_phase(LAS unsigned char* lds, const Gemm g, const Sched& S, const Epi& E) {
    const int tid = threadIdx.x, wid = __builtin_amdgcn_readfirstlane(tid >> 6), lane = tid & 63, wr = wid >> 2, wc = wid & 3, fr = lane & 15, fq = lane >> 4;
    const int K = g.K, nt = K / BK;
    unsigned voffA[2], voffB[2];
#pragma unroll
    for (int i = 0; i < 2; ++i) { int R, C; stage_rc(tid * 16 + i * 8192, R, C); const int Rb = Epi::PERM ? ((R & ~31) + perm32(R & 31)) : R;
        voffA[i] = (unsigned)(R * g.lda + C) * 2u; voffB[i] = (unsigned)(Rb * g.ldb + C) * 2u; }
    const size_t kstep = (size_t)(BK * 2);
    const size_t hstepA = (size_t)HALF * g.lda * 2, hstepB = (size_t)HALF * g.ldb * 2;
    const size_t tstepA = 2 * hstepA, tstepB = 2 * hstepB;
    const unsigned ldsw = (unsigned)wid * 1024u;
    const int aoff = lds_byte(wr * 64 + fr, fq * 8), boff = lds_byte(wc * 32 + fr, fq * 8);
#define PG8_SA(b, h) (((b) * 2 + (h)) * HTB)
#define PG8_SB(b, h) ((4 + (b) * 2 + (h)) * HTB)
#define PG8_STAGE(bufoff, gbase, voff) do { _Pragma("unroll") for (int _i = 0; _i < 2; ++_i) \
        __builtin_amdgcn_global_load_lds((const unsigned*)((const char*)(gbase) + (voff)[_i]), (LAS unsigned*)(lds + (bufoff) + ldsw + _i * 8192), 16, 0, 0); } while (0)
#define PG8_LDA(dst, b, h) do { _Pragma("unroll") for (int m = 0; m < 4; ++m) _Pragma("unroll") for (int k = 0; k < 2; ++k) dst[m][k] = *(const LAS bf16x8*)(lds + PG8_SA(b, h) + aoff + m * 2048 + k * 1024); } while (0)
#define PG8_LDB(dst, b, h) do { _Pragma("unroll") for (int n = 0; n < 2; ++n) _Pragma("unroll") for (int k = 0; k < 2; ++k) dst[n][k] = *(const LAS bf16x8*)(lds + PG8_SB(b, h) + boff + n * 2048 + k * 1024); } while (0)
#define PG8_MMA(ai, bj, At, Bt) do { __builtin_amdgcn_s_setprio(1); _Pragma("unroll") for (int m = 0; m < 4; ++m) _Pragma("unroll") for (int n = 0; n < 2; ++n) _Pragma("unroll") for (int k = 0; k < 2; ++k) \
        acc[ai][bj][m][n] = __builtin_amdgcn_mfma_f32_16x16x32_bf16(Bt[n][k], At[m][k], acc[ai][bj][m][n], 0, 0, 0); __builtin_amdgcn_s_setprio(0); } while (0)
#define PG8_WAIT_V(n) asm volatile("s_waitcnt vmcnt(" #n ")" ::: "memory")
#define PG8_WAIT_L(n) asm volatile("s_waitcnt lgkmcnt(" #n ")" ::: "memory")
#define PG8_BAR __builtin_amdgcn_s_barrier()
#define PG8_SCHED __builtin_amdgcn_sched_barrier(0)
    Unit cur, nxt; int ui = 0;
    if (!S.next(0, cur)) return;
    f32x4 acc[2][2][4][2];
#pragma unroll
    for (int a = 0; a < 2; ++a)
#pragma unroll
        for (int b = 0; b < 2; ++b)
#pragma unroll
            for (int m = 0; m < 4; ++m)
#pragma unroll
                for (int n = 0; n < 2; ++n) acc[a][b][m][n] = (f32x4){0.f, 0.f, 0.f, 0.f};
    bf16x8 At[4][2], B0[2][2], B1[2][2];
    const char* cA = (const char*)g.A + (size_t)cur.pm * tstepA + (size_t)cur.ka * 2; const char* cB = (const char*)g.Bt + (size_t)cur.pn * tstepB;
    PG8_STAGE(PG8_SB(0, 0), cB, voffB); PG8_STAGE(PG8_SA(0, 0), cA, voffA); PG8_STAGE(PG8_SB(0, 1), cB + hstepB, voffB); PG8_STAGE(PG8_SA(0, 1), cA + hstepA, voffA);
    if (wr == 1) PG8_BAR;
    PG8_WAIT_V(4); PG8_BAR;
    PG8_STAGE(PG8_SB(1, 0), cB + kstep, voffB); PG8_STAGE(PG8_SA(1, 0), cA + kstep, voffA); PG8_STAGE(PG8_SB(1, 1), cB + hstepB + kstep, voffB);
    PG8_WAIT_V(6); PG8_BAR;
    for (;;) {
        const bool has_next = S.next(ui + 1, nxt);
        const char* nA = has_next ? (const char*)g.A + (size_t)nxt.pm * tstepA + (size_t)nxt.ka * 2 : cA; const char* nB = has_next ? (const char*)g.Bt + (size_t)nxt.pn * tstepB : cB;
        for (int t = 0; t < nt; t += 2) {
            const bool last = (t == nt - 2);
            const char* a1 = cA + (size_t)(t + 1) * kstep;
            const char* a2 = last ? nA : cA + (size_t)(t + 2) * kstep; const char* b2 = last ? nB : cB + (size_t)(t + 2) * kstep;
            const char* a3 = a2 + kstep; const char* b3 = b2 + kstep;
            PG8_LDB(B0, 0, 0); PG8_SCHED; PG8_LDA(At, 0, 0); PG8_STAGE(PG8_SA(1, 1), a1 + hstepA, voffA);
            PG8_WAIT_L(8); PG8_BAR; PG8_WAIT_L(0); PG8_MMA(0, 0, At, B0); PG8_BAR; PG8_SCHED;
            PG8_LDB(B1, 0, 1); PG8_STAGE(PG8_SB(0, 0), b2, voffB);
            PG8_BAR; PG8_WAIT_L(0); PG8_MMA(0, 1, At, B1); PG8_BAR;
            PG8_LDA(At, 0, 1); PG8_STAGE(PG8_SA(0, 0), a2, voffA);
            PG8_BAR; PG8_WAIT_L(0); PG8_MMA(1, 0, At, B0); PG8_BAR; PG8_SCHED;
            PG8_STAGE(PG8_SB(0, 1), b2 + hstepB, voffB);
            PG8_WAIT_V(6); PG8_BAR; PG8_MMA(1, 1, At, B1); PG8_BAR;
            PG8_LDB(B0, 1, 0); PG8_SCHED; PG8_LDA(At, 1, 0); PG8_STAGE(PG8_SA(0, 1), a2 + hstepA, voffA);
            PG8_WAIT_L(8); PG8_BAR; PG8_WAIT_L(0); PG8_MMA(0, 0, At, B0); PG8_BAR; PG8_SCHED;
            PG8_LDB(B1, 1, 1); PG8_STAGE(PG8_SB(1, 0), b3, voffB);
            PG8_BAR; PG8_WAIT_L(0); PG8_MMA(0, 1, At, B1); PG8_BAR;
            PG8_LDA(At, 1, 1); PG8_STAGE(PG8_SA(1, 0), a3, voffA);
            PG8_BAR; PG8_WAIT_L(0); PG8_MMA(1, 0, At, B0); PG8_BAR; PG8_SCHED;
            PG8_STAGE(PG8_SB(1, 1), b3 + hstepB, voffB);
            PG8_WAIT_V(6); PG8_BAR; PG8_MMA(1, 1, At, B1); PG8_BAR;
        }
        E(acc, cur, wr, wc, fr, fq);
        if (!has_next) break;
#pragma unroll
        for (int a = 0; a < 2; ++a)
#pragma unroll
            for (int b = 0; b < 2; ++b)
#pragma unroll
                for (int m = 0; m < 4; ++m)
#pragma unroll
                    for (int n = 0; n < 2; ++n) acc[a][b][m][n] = (f32x4){0.f, 0.f, 0.f, 0.f};
        cur = nxt; cA = nA; cB = nB; ++ui;
    }
    PG8_WAIT_V(0);
    if (wr == 0) PG8_BAR;
    PG8_BAR;
#undef PG8_SA
#undef PG8_SB
#undef PG8_STAGE
#undef PG8_LDA
#undef PG8_LDB
#undef PG8_MMA
#undef PG8_WAIT_V
#undef PG8_WAIT_L
#undef PG8_BAR
#undef PG8_SCHED
}

struct SchedGrid {
    int nM, nN, G, c, kaMode;
    __device__ bool next(int i, Unit& u) const {
        const int L = i * G + c; if (L >= nM * nN) return false;
        std_tile(L, nM, nN, u.pm, u.pn);
        u.ka = kaMode == 0 ? 0 : (kaMode == 1 ? (u.pn & ~1) * 128 : u.pn * 256);
        return true;
    }
};
struct Sched1 {
    int G, c;
    __device__ bool next(int i, Unit& u) const {
        const int L = i * G + c; u.ka = 0;
        if (L < 32 * 48) { std_tile(L, 32, 48, u.pm, u.pn); return true; }
        const int j = L - 32 * 48; if (j >= 32) return false;
        u.pm = 33 + (j >> 3); u.pn = 48 + (j & 7); return true;
    }
};
struct SchedMKV {
    int G, c;
    __device__ bool next(int i, Unit& u) const { const int L = i * G + c; if (L >= 32) return false; u.pm = 33 + (L >> 3); u.pn = 48 + (L & 7); u.ka = 0; return true; }
};
struct Sched5 {
    int G, c;
    __device__ bool next(int i, Unit& u) const {
        const int T = (i / 3) * G + c, j = i % 3; if (T >= 32 * 8) return false;
        int pm, pn; std_tile(T, 32, 8, pm, pn);
        u.pm = j * 33 + pm; u.pn = j * 8 + pn; u.ka = 0; return true;
    }
};

struct Epi1 {
    static constexpr bool PERM = true;
    bf16_t* Z; float* omk; float* omv; bf16_t* MKB; bf16_t* VTB;
    __device__ __forceinline__ void operator()(const f32x4 (&acc)[2][2][4][2], const Unit& u, int wr, int wc, int fr, int fq) const {
        if (u.pn < 48) {
            const int row0 = u.pm * BM + wr * 64 + fr, col0 = u.pn * BM + wc * 32 + 8 * fq;
#pragma unroll
            for (int ai = 0; ai < 2; ++ai)
#pragma unroll
                for (int m = 0; m < 4; ++m) { bf16_t* rowp = Z + (size_t)(row0 + ai * HALF + m * 16) * INW + col0;
#pragma unroll
                    for (int bj = 0; bj < 2; ++bj) { const f32x4 v0 = acc[ai][bj][m][0], v1 = acc[ai][bj][m][1];
                        u32x4 w; w.x = cvt_pk_bf16(v0[0], v0[1]); w.y = cvt_pk_bf16(v0[2], v0[3]); w.z = cvt_pk_bf16(v1[0], v1[1]); w.w = cvt_pk_bf16(v1[2], v1[3]);
                        *(u32x4*)(rowp + bj * HALF) = w; } }
        } else {
            const int row0 = (u.pm - 33) * BM + wr * 64 + fr, col0 = (u.pn - 48) * BM + wc * 32 + 8 * fq;
            const bool isv = (u.pn - 48) >= 4;
#pragma unroll
            for (int ai = 0; ai < 2; ++ai)
#pragma unroll
                for (int m = 0; m < 4; ++m) { const int row = row0 + ai * HALF + m * 16;
#pragma unroll
                    for (int bj = 0; bj < 2; ++bj) { const f32x4 v0 = acc[ai][bj][m][0], v1 = acc[ai][bj][m][1]; const int col = col0 + bj * HALF;
                        if (!isv) {
                            float* o = omk + (size_t)row * 1024 + col; *(f32x4*)o = v0; *(f32x4*)(o + 4) = v1;
                            u32x4 w; w.x = cvt_pk_bf16(v0[0], v0[1]); w.y = cvt_pk_bf16(v0[2], v0[3]); w.z = cvt_pk_bf16(v1[0], v1[1]); w.w = cvt_pk_bf16(v1[2], v1[3]);
                            *(u32x4*)(MKB + (size_t)row * 1024 + col) = w;
                        } else {
                            const int cm = col - 1024; float* o = omv + (size_t)row * 1024 + cm; *(f32x4*)o = v0; *(f32x4*)(o + 4) = v1;
                            bf16_t* vt = VTB + ((size_t)(row >> 8) * 1024 + cm) * 256 + (row & 255);
#pragma unroll
                            for (int e = 0; e < 4; ++e) { vt[(size_t)e * 256] = f2bf(v0[e]); vt[(size_t)(e + 4) * 256] = f2bf(v1[e]); }
                        } } }
        }
    }
};
struct Epi3 {
    static constexpr bool PERM = false;
    const bf16_t* __restrict__ XR; float* __restrict__ SA; float* __restrict__ SU; const float* ba; const float* bx; const float* lam;
    __device__ __forceinline__ void operator()(const f32x4 (&acc)[2][2][4][2], const Unit& u, int wr, int wc, int fr, int fq) const {
        const int row0 = u.pm * BM + wr * 64 + fr, ch0 = u.pn * 128 + wc * 32 + 4 * fq;
        u32x2 xw[2][2][4];
#pragma unroll
        for (int n = 0; n < 2; ++n)
#pragma unroll
            for (int ai = 0; ai < 2; ++ai)
#pragma unroll
                for (int m = 0; m < 4; ++m) xw[n][ai][m] = *(const u32x2*)(XR + (size_t)(row0 + ai * HALF + m * 16) * 1024 + ch0 + n * 16);
#pragma unroll
        for (int n = 0; n < 2; ++n) {
            const int ch = ch0 + n * 16;
            const f32x4 vba = *(const f32x4*)(ba + ch), vbx = *(const f32x4*)(bx + ch), l = *(const f32x4*)(lam + ch); f32x4 vsp;
#pragma unroll
            for (int j = 0; j < 4; ++j) { const float ex = fast_exp(-l[j]);
                const float sp = ex < 0.03f ? ex * (1.0f + ex * (-0.5f + ex * (0.33333333f - 0.25f * ex))) : __logf(1.0f + ex); vsp[j] = -8.0f * sp; }
#pragma unroll
            for (int ai = 0; ai < 2; ++ai)
#pragma unroll
                for (int m = 0; m < 4; ++m) { const int row = row0 + ai * HALF + m * 16; if (row >= TT) continue;
                    const u32x2 xv = xw[n][ai][m];
                    const float xr[4] = {bf_lo(xv.x), bf_hi(xv.x), bf_lo(xv.y), bf_hi(xv.y)}; f32x4 av, uv;
#pragma unroll
                    for (int j = 0; j < 4; ++j) { const float r = sigmoidf_(acc[ai][0][m][n][j] + vba[j]), ig = sigmoidf_(acc[ai][1][m][n][j] + vbx[j]);
                        const float la = vsp[j] * r; av[j] = fast_exp(la); uv[j] = __builtin_amdgcn_sqrtf(fmaxf(1.0f - fast_exp(2.0f * la), 0.f)) * ig * xr[j]; }
                    *(f32x4*)(SA + (size_t)row * 1024 + ch) = av; *(f32x4*)(SU + (size_t)row * 1024 + ch) = uv; }
        }
    }
};
struct Epi5 {
    static constexpr bool PERM = true;
    const bf16_t* __restrict__ Z; bf16_t* __restrict__ P0; bf16_t* __restrict__ P1; bf16_t* __restrict__ MB;
    __device__ __forceinline__ void operator()(const f32x4 (&acc)[2][2][4][2], const Unit& u, int wr, int wc, int fr, int fq) const {
        const int j = u.pn >> 3, pm = u.pm - j * 33, pn = u.pn & 7;
        const int row0 = pm * BM + wr * 64 + fr, col0 = pn * BM + wc * 32 + 8 * fq;
        const bf16_t* __restrict__ src = (j == 1) ? P0 : P1; bf16_t* __restrict__ dst = (j == 0) ? P0 : (j == 1 ? P1 : MB);
#pragma unroll
        for (int ai = 0; ai < 2; ++ai) {
            u32x4 gw[4][2], pw[4][2];
#pragma unroll
            for (int m = 0; m < 4; ++m)
#pragma unroll
                for (int bj = 0; bj < 2; ++bj) { const int row = row0 + ai * HALF + m * 16, col = col0 + bj * HALF;
                    gw[m][bj] = *(const u32x4*)(Z + (size_t)row * INW + 6144 + j * 2048 + col);
                    pw[m][bj] = (j > 0) ? *(const u32x4*)(src + (size_t)row * DM + col) : (u32x4){0u, 0u, 0u, 0u}; }
#pragma unroll
            for (int m = 0; m < 4; ++m)
#pragma unroll
                for (int bj = 0; bj < 2; ++bj) { const int row = row0 + ai * HALF + m * 16, col = col0 + bj * HALF;
                    float gv[8], pv[8], r[8]; unpack8(gw[m][bj], gv); unpack8(pw[m][bj], pv);
#pragma unroll
                    for (int e = 0; e < 4; ++e) { r[e] = sigmoidf_(gv[e]) * acc[ai][bj][m][0][e] + pv[e]; r[e + 4] = sigmoidf_(gv[e + 4]) * acc[ai][bj][m][1][e] + pv[e + 4]; }
                    *(u32x4*)(dst + (size_t)row * DM + col) = pack8(r); }
        }
    }
};
struct Epi6 {
    static constexpr bool PERM = false;
    const float* xp; const float* xs; float* H1;
    __device__ __forceinline__ void operator()(const f32x4 (&acc)[2][2][4][2], const Unit& u, int wr, int wc, int fr, int fq) const {
        const int row0 = u.pm * BM + wr * 64 + fr, col0 = u.pn * BM + wc * 32 + 4 * fq;
#pragma unroll
        for (int ai = 0; ai < 2; ++ai)
#pragma unroll
            for (int m = 0; m < 4; ++m) { const int row = row0 + ai * HALF + m * 16; if (row >= TT) continue;
                const float* xrow = row < TP ? xp + (size_t)row * DM : xs + (size_t)(row - TP) * DM;
#pragma unroll
                for (int bj = 0; bj < 2; ++bj)
#pragma unroll
                    for (int n = 0; n < 2; ++n) { const int col = col0 + bj * HALF + n * 16; const f32x4 xv = *(const f32x4*)(xrow + col);
                        *(f32x4*)(H1 + (size_t)row * DM + col) = xv * DN_ALPHA + acc[ai][bj][m][n]; } }
    }
};
struct EpiB {
    static constexpr bool PERM = true;
    bf16_t* O; int ldc;
    __device__ __forceinline__ void operator()(const f32x4 (&acc)[2][2][4][2], const Unit& u, int wr, int wc, int fr, int fq) const {
        const int row0 = u.pm * BM + wr * 64 + fr, col0 = u.pn * BM + wc * 32 + 8 * fq;
#pragma unroll
        for (int ai = 0; ai < 2; ++ai)
#pragma unroll
            for (int m = 0; m < 4; ++m) { bf16_t* rowp = O + (size_t)(row0 + ai * HALF + m * 16) * ldc + col0;
#pragma unroll
                for (int bj = 0; bj < 2; ++bj) { const f32x4 v0 = acc[ai][bj][m][0], v1 = acc[ai][bj][m][1];
                    u32x4 w; w.x = cvt_pk_bf16(v0[0], v0[1]); w.y = cvt_pk_bf16(v0[2], v0[3]); w.z = cvt_pk_bf16(v1[0], v1[1]); w.w = cvt_pk_bf16(v1[2], v1[3]);
                    *(u32x4*)(rowp + bj * HALF) = w; } }
    }
};
struct EpiF {
    static constexpr bool PERM = false;
    float* C; int ldc;
    __device__ __forceinline__ void operator()(const f32x4 (&acc)[2][2][4][2], const Unit& u, int wr, int wc, int fr, int fq) const {
        const int row0 = u.pm * BM + wr * 64 + fr, col0 = u.pn * BM + wc * 32 + 4 * fq;
#pragma unroll
        for (int ai = 0; ai < 2; ++ai)
#pragma unroll
            for (int m = 0; m < 4; ++m) { float* rowp = C + (size_t)(row0 + ai * HALF + m * 16) * ldc + col0;
#pragma unroll
                for (int bj = 0; bj < 2; ++bj)
#pragma unroll
                    for (int n = 0; n < 2; ++n) *(f32x4*)(rowp + bj * HALF + n * 16) = acc[ai][bj][m][n]; }
    }
};

__device__ void cvt_flat(const float* __restrict__ src, bf16_t* __restrict__ dst, size_t n, size_t gtid, size_t gth) {
    for (size_t i = gtid * 8; i < n; i += gth * 8) {
        const f32x4 a = *(const f32x4*)(src + i), b = *(const f32x4*)(src + i + 4);
        u32x4 w; w.x = cvt_pk_bf16(a[0], a[1]); w.y = cvt_pk_bf16(a[2], a[3]); w.z = cvt_pk_bf16(b[0], b[1]); w.w = cvt_pk_bf16(b[2], b[3]);
        *(u32x4*)(dst + i) = w;
    }
}
__device__ void transpose_cvt(float* lds, const float* __restrict__ src, bf16_t* __restrict__ dst, int K, int N, int bid, int nb) {
    const int tn = N / 64, ntile = (K / 64) * tn;
    for (int t = bid; t < ntile; t += nb) {
        const int k0 = (t / tn) * 64, n0 = (t % tn) * 64;
#pragma unroll
        for (int i = 0; i < 2; ++i) { const int idx = threadIdx.x + i * 512, r = idx >> 4, c4 = (idx & 15) * 4;
            const f32x4 v = *(const f32x4*)(src + (size_t)(k0 + r) * N + n0 + c4);
            lds[r * 65 + c4] = v[0]; lds[r * 65 + c4 + 1] = v[1]; lds[r * 65 + c4 + 2] = v[2]; lds[r * 65 + c4 + 3] = v[3]; }
        __syncthreads();
        { const int n = threadIdx.x >> 3, kc = (threadIdx.x & 7) * 8; float v[8];
#pragma unroll
            for (int i = 0; i < 8; ++i) v[i] = lds[(kc + i) * 65 + n];
            *(u32x4*)(dst + (size_t)(n0 + n) * K + k0 + kc) = pack8(v); }
        __syncthreads();
    }
}


__device__ void cvt_fp8_rows(const float* __restrict__ src, unsigned char* __restrict__ dst, float* __restrict__ inv, int nrows, int gw, int nw) {
    const int lane = threadIdx.x & 63;
    for (int row = gw; row < nrows; row += nw) {
        f32x4 v[2][4]; float mx = 0.f;
#pragma unroll
        for (int j = 0; j < 2; ++j)
#pragma unroll
            for (int q = 0; q < 4; ++q) { v[j][q] = *(const f32x4*)(src + (size_t)row * 2048 + j * 1024 + lane * 16 + q * 4);
                mx = fmaxf(mx, fmaxf(fmaxf(fabsf(v[j][q][0]), fabsf(v[j][q][1])), fmaxf(fabsf(v[j][q][2]), fabsf(v[j][q][3])))); }
#pragma unroll
        for (int o = 32; o > 0; o >>= 1) mx = fmaxf(mx, __shfl_xor(mx, o, 64));
        int k = 8 - ((int)((__float_as_uint(mx) >> 23) & 0xffu) - 126); k = k > 100 ? 100 : (k < -100 ? -100 : k);
        if (mx == 0.f) k = 0;
        const float sc = __uint_as_float((unsigned)(127 + k) << 23), isc = __uint_as_float((unsigned)(127 - k) << 23);
#pragma unroll
        for (int j = 0; j < 2; ++j) { u32x4 w;
#pragma unroll
            for (int q = 0; q < 4; ++q) { int t = 0; t = __builtin_amdgcn_cvt_pk_fp8_f32(v[j][q][0] * sc, v[j][q][1] * sc, t, false); t = __builtin_amdgcn_cvt_pk_fp8_f32(v[j][q][2] * sc, v[j][q][3] * sc, t, true); w[q] = (unsigned)t; }
            *(u32x4*)(dst + (size_t)row * 2048 + j * 1024 + lane * 16) = w; }
        if (lane == 0) inv[row] = isc;
    }
}

__device__ void phase0(const Params& p, float* lds) {
    const int bid = blockIdx.x, nb = gridDim.x; const size_t gtid = (size_t)bid * 512 + threadIdx.x, gth = (size_t)nb * 512;
    unsigned char* ws = p.ws;
    bf16_t* AALL = (bf16_t*)(ws + W_AALL); bf16_t* BTALL = (bf16_t*)(ws + W_BTALL);
    transpose_cvt(lds, p.in[8], BTALL, 2048, 12288, bid, nb);
    transpose_cvt(lds, p.in[17], BTALL + (size_t)12288 * 2048, 2048, 1024, bid, nb);
    transpose_cvt(lds, p.in[18], BTALL + (size_t)13312 * 2048, 2048, 1024, bid, nb);
    transpose_cvt(lds, p.in[19], (bf16_t*)(ws + W_WBRT), 1024, 2048, bid, nb);
    transpose_cvt(lds, p.in[20], (bf16_t*)(ws + W_WBRT) + (size_t)2048 * 1024, 1024, 2048, bid, nb);
    transpose_cvt(lds, p.in[21], (bf16_t*)(ws + W_WBRT) + (size_t)2 * 2048 * 1024, 1024, 2048, bid, nb);
    transpose_cvt(lds, p.in[22], (bf16_t*)(ws + W_WOT), 2048, 2048, bid, nb);
    transpose_cvt(lds, p.in[25], (bf16_t*)(ws + W_WQT), 2048, 2048, bid, nb);
    cvt_flat(p.in[0], AALL, (size_t)TP * DM, gtid, gth);
    cvt_flat(p.in[1], AALL + (size_t)TP * DM, (size_t)TS * DM, gtid, gth);
    cvt_flat(p.in[2], AALL + (size_t)TPAD * DM, (size_t)NMEM * DM, gtid, gth);
    bf16_t* WGT = (bf16_t*)(ws + W_WGT); bf16_t* WKT = (bf16_t*)(ws + W_WKT);
    for (size_t idx = gtid; idx < (size_t)2048 * 256; idx += gth) {
        const int k = (int)(idx & 255), ng = (int)(idx >> 8), h = ng >> 8, n = ng & 255;
        float v = 0.f;
        if ((k >> 7) == (h & 1)) { const float* w = (n < 128) ? p.in[12] : p.in[14]; v = w[((size_t)h * 128 + (k & 127)) * 128 + (n & 127)]; }
        WGT[idx] = f2bf(v);
        float v2 = 0.f; const int c = n >> 7;
        if ((k >> 7) == c) v2 = p.in[26][(((size_t)h * 2 + c) * 128 + (n & 127)) * 128 + (k & 127)];
        WKT[idx] = f2bf(v2);
    }
}

__device__ __forceinline__ u32x4 ldz(const bf16_t* Z, int t, int col) { return *(const u32x4*)(Z + (size_t)t * INW + col); }

__device__ void p2_elem_prompt(const Params& p, int item) {
    const int TIDX = launder_tid();
    const bf16_t* __restrict__ Z = (const bf16_t*)(p.ws + W_Z); bf16_t* __restrict__ Y0 = (bf16_t*)(p.ws + W_YCAT); bf16_t* __restrict__ XR = (bf16_t*)(p.ws + W_XR);
    const int run = item * 4 + (TIDX >> 7), c0 = (TIDX & 127) * 8, t0 = run * 16, b = t0 >> 11, s0 = t0 & 2047;
    float cw[3][8], rw[4][8], rb[8];
#pragma unroll
    for (int k = 0; k < 3; ++k) { const f32x4 a = *(const f32x4*)(p.in[9] + k * 1024 + c0), bb = *(const f32x4*)(p.in[9] + k * 1024 + c0 + 4);
#pragma unroll
        for (int e = 0; e < 4; ++e) { cw[k][e] = a[e]; cw[k][e + 4] = bb[e]; } }
#pragma unroll
    for (int k = 0; k < 4; ++k) { const f32x4 a = *(const f32x4*)(p.in[10] + k * 1024 + c0), bb = *(const f32x4*)(p.in[10] + k * 1024 + c0 + 4);
#pragma unroll
        for (int e = 0; e < 4; ++e) { rw[k][e] = a[e]; rw[k][e + 4] = bb[e]; } }
    { const f32x4 a = *(const f32x4*)(p.in[11] + c0), bb = *(const f32x4*)(p.in[11] + c0 + 4);
#pragma unroll
        for (int e = 0; e < 4; ++e) { rb[e] = a[e]; rb[e + 4] = bb[e]; } }
    float z2[8], z1[8], r3[8], r2[8], r1[8];
#pragma unroll
    for (int e = 0; e < 8; ++e) { z2[e] = z1[e] = r3[e] = r2[e] = r1[e] = 0.f; }
    if (s0 > 0) {
        float a[8], bb[8];
        unpack8(ldz(Z, t0 - 2, 1024 + c0), a); unpack8(ldz(Z, t0 - 2, 2048 + c0), bb);
#pragma unroll
        for (int e = 0; e < 8; ++e) z2[e] = a[e] * bb[e];
        unpack8(ldz(Z, t0 - 1, 1024 + c0), a); unpack8(ldz(Z, t0 - 1, 2048 + c0), bb);
#pragma unroll
        for (int e = 0; e < 8; ++e) z1[e] = a[e] * bb[e];
        unpack8(ldz(Z, t0 - 3, 3072 + c0), r3); unpack8(ldz(Z, t0 - 2, 3072 + c0), r2); unpack8(ldz(Z, t0 - 1, 3072 + c0), r1);
    }
#pragma unroll 1
    for (int sb = 0; sb < 16; sb += 4) {
        u32x4 wcb[4], wcc[4], wcx[4], wrx[4];
#pragma unroll
        for (int s = 0; s < 4; ++s) { const int t = t0 + sb + s; wcb[s] = ldz(Z, t, c0); wcc[s] = ldz(Z, t, 1024 + c0); wcx[s] = ldz(Z, t, 2048 + c0); wrx[s] = ldz(Z, t, 3072 + c0); }
#pragma unroll
        for (int s = 0; s < 4; ++s) {
            const int t = t0 + sb + s, sq = s0 + sb + s;
            float cb[8], cc[8], cx[8], rx[8], zc[8], yc[8], xr[8];
            unpack8(wcb[s], cb); unpack8(wcc[s], cc); unpack8(wcx[s], cx); unpack8(wrx[s], rx);
#pragma unroll
            for (int e = 0; e < 8; ++e) { zc[e] = cc[e] * cx[e]; yc[e] = cb[e] * (cw[0][e] * z2[e] + cw[1][e] * z1[e] + cw[2][e] * zc[e]);
                xr[e] = rw[0][e] * r3[e] + rw[1][e] * r2[e] + rw[2][e] * r1[e] + rw[3][e] * rx[e] + rb[e]; }
            *(u32x4*)(Y0 + (size_t)t * 1024 + c0) = pack8(yc);
            *(u32x4*)(XR + (size_t)t * 1024 + c0) = pack8(xr);
            if (sq >= 2046) { float* o = p.out + O_CZP + ((size_t)b * 2 + (sq - 2046)) * 1024 + c0; *(f32x4*)o = (f32x4){zc[0], zc[1], zc[2], zc[3]}; *(f32x4*)(o + 4) = (f32x4){zc[4], zc[5], zc[6], zc[7]}; }
            if (sq >= 2045) { float* o = p.out + O_RCP + ((size_t)b * 3 + (sq - 2045)) * 1024 + c0; *(f32x4*)o = (f32x4){rx[0], rx[1], rx[2], rx[3]}; *(f32x4*)(o + 4) = (f32x4){rx[4], rx[5], rx[6], rx[7]}; }
#pragma unroll
            for (int e = 0; e < 8; ++e) { z2[e] = z1[e]; z1[e] = zc[e]; r3[e] = r2[e]; r2[e] = r1[e]; r1[e] = rx[e]; }
        }
    }
}
__device__ __forceinline__ void ld8f(const float* p, float* v) { const f32x4 a = *(const f32x4*)p, b = *(const f32x4*)(p + 4);
#pragma unroll
    for (int e = 0; e < 4; ++e) { v[e] = a[e]; v[e + 4] = b[e]; } }
__device__ __forceinline__ void st8f(float* p, const float* v) { *(f32x4*)p = (f32x4){v[0], v[1], v[2], v[3]}; *(f32x4*)(p + 4) = (f32x4){v[4], v[5], v[6], v[7]}; }

__device__ void p2_elem_sample(const Params& p, int item) {
    const int TIDX = launder_tid();
    const bf16_t* Z = (const bf16_t*)(p.ws + W_Z); bf16_t* Y0 = (bf16_t*)(p.ws + W_YCAT); bf16_t* XR = (bf16_t*)(p.ws + W_XR);
    const int bs = item * 4 + (TIDX >> 7), c0 = (TIDX & 127) * 8, t = TP + bs;
    float cw[3][8], rw[4][8], rb[8], z2[8], z1[8], r3[8], r2[8], r1[8];
#pragma unroll
    for (int k = 0; k < 3; ++k) ld8f(p.in[9] + k * 1024 + c0, cw[k]);
#pragma unroll
    for (int k = 0; k < 4; ++k) ld8f(p.in[10] + k * 1024 + c0, rw[k]);
    ld8f(p.in[11] + c0, rb);
    ld8f(p.in[5] + ((size_t)bs * 2 + 0) * 1024 + c0, z2); ld8f(p.in[5] + ((size_t)bs * 2 + 1) * 1024 + c0, z1);
    ld8f(p.in[6] + ((size_t)bs * 3 + 0) * 1024 + c0, r3); ld8f(p.in[6] + ((size_t)bs * 3 + 1) * 1024 + c0, r2); ld8f(p.in[6] + ((size_t)bs * 3 + 2) * 1024 + c0, r1);
    float cb[8], cc[8], cx[8], rx[8], zc[8], yc[8], xr[8];
    unpack8(ldz(Z, t, c0), cb); unpack8(ldz(Z, t, 1024 + c0), cc); unpack8(ldz(Z, t, 2048 + c0), cx); unpack8(ldz(Z, t, 3072 + c0), rx);
#pragma unroll
    for (int e = 0; e < 8; ++e) { zc[e] = cc[e] * cx[e]; yc[e] = cb[e] * (cw[0][e] * z2[e] + cw[1][e] * z1[e] + cw[2][e] * zc[e]);
        xr[e] = rw[0][e] * r3[e] + rw[1][e] * r2[e] + rw[2][e] * r1[e] + rw[3][e] * rx[e] + rb[e]; }
    *(u32x4*)(Y0 + (size_t)t * 1024 + c0) = pack8(yc);
    *(u32x4*)(XR + (size_t)t * 1024 + c0) = pack8(xr);
    st8f(p.out + O_CZS + ((size_t)bs * 2 + 0) * 1024 + c0, z1); st8f(p.out + O_CZS + ((size_t)bs * 2 + 1) * 1024 + c0, zc);
    st8f(p.out + O_RCS + ((size_t)bs * 3 + 0) * 1024 + c0, r2); st8f(p.out + O_RCS + ((size_t)bs * 3 + 1) * 1024 + c0, r1); st8f(p.out + O_RCS + ((size_t)bs * 3 + 2) * 1024 + c0, rx);
}

__device__ void p2_attn_prompt(const Params& p, int item) {
    const bf16_t* Z = (const bf16_t*)(p.ws + W_Z); const bf16_t* MKB = (const bf16_t*)(p.ws + W_MKB); const bf16_t* VTB = (const bf16_t*)(p.ws + W_VTB);
    bf16_t* Y2 = (bf16_t*)(p.ws + W_YCAT) + (size_t)2 * TPAD * 1024;
    const int b = item >> 6, h = (item >> 4) & 3, qt = item & 15;
    const int w = threadIdx.x >> 6, lane = threadIdx.x & 63, fr = lane & 15, fq = lane >> 4;
    const int t = b * 2048 + qt * 128 + w * 16 + fr;
    bf16x8 qf[8];
#pragma unroll
    for (int ks = 0; ks < 8; ++ks) qf[ks] = *(const bf16x8*)(Z + (size_t)t * INW + 5120 + h * 256 + ks * 32 + fq * 8);
    f32x4 sacc[16];
#pragma unroll
    for (int nb = 0; nb < 16; ++nb) {
        sacc[nb] = (f32x4){0.f, 0.f, 0.f, 0.f};
        const bf16_t* kp = MKB + (size_t)(b * 256 + nb * 16 + fr) * 1024 + h * 256 + fq * 8;
#pragma unroll
        for (int ks = 0; ks < 8; ++ks) { const bf16x8 kf = *(const bf16x8*)(kp + ks * 32); sacc[nb] = __builtin_amdgcn_mfma_f32_16x16x32_bf16(kf, qf[ks], sacc[nb], 0, 0, 0); }
    }
    float mx = -3.0e38f;
#pragma unroll
    for (int nb = 0; nb < 16; ++nb)
#pragma unroll
        for (int j = 0; j < 4; ++j) { sacc[nb][j] *= 0.0625f; mx = fmaxf(mx, sacc[nb][j]); }
    mx = fmaxf(mx, __shfl_xor(mx, 16, 64)); mx = fmaxf(mx, __shfl_xor(mx, 32, 64));
    float sum = 0.f;
#pragma unroll
    for (int nb = 0; nb < 16; ++nb)
#pragma unroll
        for (int j = 0; j < 4; ++j) { sacc[nb][j] = fast_exp(sacc[nb][j] - mx); sum += sacc[nb][j]; }
    sum += __shfl_xor(sum, 16, 64); sum += __shfl_xor(sum, 32, 64);
    const float inv = 1.0f / sum;
    bf16x8 pf[8];
#pragma unroll
    for (int s2 = 0; s2 < 8; ++s2) {
        u32x4 w4; w4.x = cvt_pk_bf16(sacc[2 * s2][0] * inv, sacc[2 * s2][1] * inv); w4.y = cvt_pk_bf16(sacc[2 * s2][2] * inv, sacc[2 * s2][3] * inv);
        w4.z = cvt_pk_bf16(sacc[2 * s2 + 1][0] * inv, sacc[2 * s2 + 1][1] * inv); w4.w = cvt_pk_bf16(sacc[2 * s2 + 1][2] * inv, sacc[2 * s2 + 1][3] * inv);
        pf[s2] = __builtin_bit_cast(bf16x8, w4);
    }
#pragma unroll 4
    for (int db = 0; db < 16; ++db) {
        f32x4 o = (f32x4){0.f, 0.f, 0.f, 0.f};
        const bf16_t* vp = VTB + ((size_t)b * 1024 + h * 256 + db * 16 + fr) * 256 + fq * 4;
#pragma unroll
        for (int s2 = 0; s2 < 8; ++s2) { const u32x2 v0 = *(const u32x2*)(vp + s2 * 32), v1 = *(const u32x2*)(vp + s2 * 32 + 16);
            u32x4 vv; vv.x = v0.x; vv.y = v0.y; vv.z = v1.x; vv.w = v1.y;
            o = __builtin_amdgcn_mfma_f32_16x16x32_bf16(__builtin_bit_cast(bf16x8, vv), pf[s2], o, 0, 0, 0); }
        u32x2 ow; ow.x = cvt_pk_bf16(o[0], o[1]); ow.y = cvt_pk_bf16(o[2], o[3]);
        *(u32x2*)(Y2 + (size_t)t * 1024 + h * 256 + db * 16 + fq * 4) = ow;
    }
}

__device__ void p2_attn_sample(const Params& p, int pair, float* lds) {
    const int TIDX = launder_tid();
    const bf16_t* Z = (const bf16_t*)(p.ws + W_Z); bf16_t* Y2 = (bf16_t*)(p.ws + W_YCAT) + (size_t)2 * TPAD * 1024;
    const int w = TIDX >> 6, lane = TIDX & 63, kq = lane >> 4, dl = lane & 15;
    const int b = pair >> 2, h = pair & 3;
    f32x4 qv[4];
#pragma unroll
    for (int j = 0; j < 4; ++j) { const u32x2 qw = *(const u32x2*)(Z + (size_t)(TP + b) * INW + 5120 + h * 256 + dl * 4 + 64 * j);
        qv[j] = (f32x4){bf_lo(qw.x), bf_hi(qw.x), bf_lo(qw.y), bf_hi(qw.y)} * 0.0625f; }
    const float* Kc = p.in[3]; const float* Vc = p.in[4];
    float sc[8];
#pragma unroll
    for (int i = 0; i < 8; ++i) {
        const int key = w * 32 + 4 * i + kq; const float* kp = Kc + (((size_t)b * 256 + key) * 4 + h) * 256 + dl * 4;
        float d = 0.f;
#pragma unroll
        for (int j = 0; j < 4; ++j) { const f32x4 kv = *(const f32x4*)(kp + 64 * j); d += kv[0] * qv[j][0] + kv[1] * qv[j][1] + kv[2] * qv[j][2] + kv[3] * qv[j][3]; }
        d += __shfl_xor(d, 1, 64); d += __shfl_xor(d, 2, 64); d += __shfl_xor(d, 4, 64); d += __shfl_xor(d, 8, 64);
        sc[i] = d;
    }
    float mx = sc[0];
#pragma unroll
    for (int i = 1; i < 8; ++i) mx = fmaxf(mx, sc[i]);
    mx = fmaxf(mx, __shfl_xor(mx, 16, 64)); mx = fmaxf(mx, __shfl_xor(mx, 32, 64));
    float l = 0.f; f32x4 o[4];
#pragma unroll
    for (int j = 0; j < 4; ++j) o[j] = (f32x4){0.f, 0.f, 0.f, 0.f};
#pragma unroll
    for (int i = 0; i < 8; ++i) {
        const float pe = fast_exp(sc[i] - mx); l += pe;
        const int key = w * 32 + 4 * i + kq; const float* vp = Vc + (((size_t)b * 256 + key) * 4 + h) * 256 + dl * 4;
#pragma unroll
        for (int j = 0; j < 4; ++j) { const f32x4 vv = *(const f32x4*)(vp + 64 * j); o[j] += vv * pe; }
    }
    l += __shfl_xor(l, 16, 64); l += __shfl_xor(l, 32, 64);
#pragma unroll
    for (int j = 0; j < 4; ++j)
#pragma unroll
        for (int e = 0; e < 4; ++e) { float v = o[j][e]; v += __shfl_xor(v, 16, 64); v += __shfl_xor(v, 32, 64); o[j][e] = v; }
    float* my = lds + w * 260;
    if (kq == 0) {
#pragma unroll
        for (int j = 0; j < 4; ++j) *(f32x4*)(my + dl * 4 + 64 * j) = o[j];
        if (dl == 0) { my[256] = mx; my[257] = l; }
    }
    __syncthreads();
    if (TIDX < 256) {
        const int d = TIDX; float M = lds[256];
#pragma unroll
        for (int ww = 1; ww < 8; ++ww) M = fmaxf(M, lds[ww * 260 + 256]);
        float L = 0.f, v = 0.f;
#pragma unroll
        for (int ww = 0; ww < 8; ++ww) { const float e = fast_exp(lds[ww * 260 + 256] - M); L += e * lds[ww * 260 + 257]; v += e * lds[ww * 260 + d]; }
        Y2[(size_t)(TP + b) * 1024 + h * 256 + d] = f2bf(v / L);
    }
    __syncthreads();
}

template <int NB>
__device__ __forceinline__ void skinny_acc(f32x4 (&acc)[NB], const bf16_t* __restrict__ Arow, const bf16_t* __restrict__ Brow, size_t nbstride, int K) {
    bf16x8 a0[4], b0[NB][4], a1[4], b1[NB][4];
#define SK_LOAD(a, b, kk) do { _Pragma("unroll") for (int s2 = 0; s2 < 4; ++s2) { a[s2] = *(const bf16x8*)(Arow + (kk) + s2 * 32); \
        _Pragma("unroll") for (int nb = 0; nb < NB; ++nb) b[nb][s2] = *(const bf16x8*)(Brow + nb * nbstride + (kk) + s2 * 32); } } while (0)
#define SK_MMA(a, b) do { _Pragma("unroll") for (int s2 = 0; s2 < 4; ++s2) _Pragma("unroll") for (int nb = 0; nb < NB; ++nb) acc[nb] = __builtin_amdgcn_mfma_f32_16x16x32_bf16(b[nb][s2], a[s2], acc[nb], 0, 0, 0); } while (0)
    SK_LOAD(a0, b0, 0);
#pragma unroll 1
    for (int k0 = 0; k0 < K; k0 += 256) {
        SK_LOAD(a1, b1, k0 + 128);
        SK_MMA(a0, b0);
        if (k0 + 256 < K) SK_LOAD(a0, b0, k0 + 256);
        SK_MMA(a1, b1);
    }
#undef SK_LOAD
#undef SK_MMA
}

template <int NB, int KB>
__device__ __forceinline__ void skinny_k(f32x4 (&acc)[NB][8], const bf16_t* __restrict__ A0, int lda, const bf16_t* __restrict__ B0, size_t nbstride, int ksteps) {
#pragma unroll 1
    for (int ks = 0; ks < ksteps; ks += KB) {
        bf16x8 a[KB][8], b[KB][NB];
#pragma unroll
        for (int s2 = 0; s2 < KB; ++s2) {
#pragma unroll
            for (int rb = 0; rb < 8; ++rb) a[s2][rb] = *(const bf16x8*)(A0 + (size_t)rb * 16 * lda + (ks + s2) * 32);
#pragma unroll
            for (int nb = 0; nb < NB; ++nb) b[s2][nb] = *(const bf16x8*)(B0 + nb * nbstride + (ks + s2) * 32); }
#pragma unroll
        for (int s2 = 0; s2 < KB; ++s2)
#pragma unroll
            for (int nb = 0; nb < NB; ++nb)
#pragma unroll
                for (int rb = 0; rb < 8; ++rb) acc[nb][rb] = __builtin_amdgcn_mfma_f32_16x16x32_bf16(b[s2][nb], a[s2][rb], acc[nb][rb], 0, 0, 0);
    }
}
__device__ __forceinline__ f32x4 xwave_reduce(float* lds, const f32x4 (&acc)[8], int w, int lane) {
    __syncthreads();
#pragma unroll
    for (int rb = 0; rb < 8; ++rb) *(f32x4*)(lds + ((w * 8 + rb) * 64 + lane) * 4) = acc[rb];
    __syncthreads();
    f32x4 v = *(const f32x4*)(lds + ((0 * 8 + w) * 64 + lane) * 4);
#pragma unroll
    for (int w2 = 1; w2 < 8; ++w2) v += *(const f32x4*)(lds + ((w2 * 8 + w) * 64 + lane) * 4);
    return v;
}
__device__ void s1_zin(const Params& p, int ti, float* lds) {
    const int w = threadIdx.x >> 6, lane = threadIdx.x & 63, fr = lane & 15, fq = lane >> 4, n0 = ti * 48, kw0 = w * 256;
    const bf16_t* A0 = (const bf16_t*)(p.ws + W_AALL) + (size_t)(TP + fr) * DM + fq * 8 + kw0; const bf16_t* B0 = (const bf16_t*)(p.ws + W_BTALL) + (size_t)(n0 + fr) * DM + fq * 8 + kw0;
    f32x4 acc[3][8];
#pragma unroll
    for (int nb = 0; nb < 3; ++nb)
#pragma unroll
        for (int rb = 0; rb < 8; ++rb) acc[nb][rb] = (f32x4){0.f, 0.f, 0.f, 0.f};
    skinny_k<3, 2>(acc, A0, DM, B0, (size_t)16 * DM, 8);
    bf16_t* Z = (bf16_t*)(p.ws + W_Z); const int row = TP + 16 * w + fr;
#pragma unroll
    for (int nb = 0; nb < 3; ++nb) { const f32x4 v = xwave_reduce(lds, acc[nb], w, lane);
        u32x2 o; o.x = cvt_pk_bf16(v[0], v[1]); o.y = cvt_pk_bf16(v[2], v[3]); *(u32x2*)(Z + (size_t)row * INW + n0 + nb * 16 + 4 * fq) = o; }
}
__device__ void s3_gates(const Params& p, int ti) {
    const int w = threadIdx.x >> 6, lane = threadIdx.x & 63, fr = lane & 15, fq = lane >> 4, row = TP + 16 * w + fr, h = ti >> 3, nb = ti & 7;
    const bf16_t* XR = (const bf16_t*)(p.ws + W_XR);
    const bf16_t* A = XR + (size_t)row * 1024 + (h & ~1) * 128 + fq * 8; const bf16_t* B = (const bf16_t*)(p.ws + W_WGT) + (size_t)(h * 256 + nb * 16 + fr) * 256 + fq * 8;
    f32x4 acc[2] = {{0.f, 0.f, 0.f, 0.f}, {0.f, 0.f, 0.f, 0.f}};
    skinny_acc<2>(acc, A, B, (size_t)128 * 256, 256);
    const int ch = h * 128 + nb * 16 + 4 * fq;
    const f32x4 vba = *(const f32x4*)(p.in[13] + ch), vbx = *(const f32x4*)(p.in[15] + ch), l = *(const f32x4*)(p.in[16] + ch);
    const u32x2 xw = *(const u32x2*)(XR + (size_t)row * 1024 + ch); const float xr[4] = {bf_lo(xw.x), bf_hi(xw.x), bf_lo(xw.y), bf_hi(xw.y)}; f32x4 av, uv;
#pragma unroll
    for (int j = 0; j < 4; ++j) { const float ex = fast_exp(-l[j]); const float sp = ex < 0.03f ? ex * (1.0f + ex * (-0.5f + ex * (0.33333333f - 0.25f * ex))) : __logf(1.0f + ex);
        const float r = sigmoidf_(acc[0][j] + vba[j]), ig = sigmoidf_(acc[1][j] + vbx[j]); const float la = -8.0f * sp * r;
        av[j] = fast_exp(la); uv[j] = __builtin_amdgcn_sqrtf(fmaxf(1.0f - fast_exp(2.0f * la), 0.f)) * ig * xr[j]; }
    *(f32x4*)((float*)(p.ws + W_SA) + (size_t)row * 1024 + ch) = av; *(f32x4*)((float*)(p.ws + W_SU) + (size_t)row * 1024 + ch) = uv;
}
__device__ void s5_merge(const Params& p, int ti, float* lds) {
    const int w = threadIdx.x >> 6, lane = threadIdx.x & 63, fr = lane & 15, fq = lane >> 4, n0 = ti * 16, col = n0 + 4 * fq, kw0 = w * 128;
    const bf16_t* Z = (const bf16_t*)(p.ws + W_Z);
    f32x4 m[8];
#pragma unroll
    for (int rb = 0; rb < 8; ++rb) m[rb] = (f32x4){0.f, 0.f, 0.f, 0.f};
#pragma unroll 1
    for (int j = 0; j < 3; ++j) {
        const bf16_t* A0 = (const bf16_t*)(p.ws + W_YCAT) + ((size_t)j * TPAD + TP + fr) * 1024 + fq * 8 + kw0; const bf16_t* B0 = (const bf16_t*)(p.ws + W_WBRT) + ((size_t)j * 2048 + n0 + fr) * 1024 + fq * 8 + kw0;
        f32x4 acc[1][8];
#pragma unroll
        for (int rb = 0; rb < 8; ++rb) acc[0][rb] = (f32x4){0.f, 0.f, 0.f, 0.f};
        u32x2 gw[8];
#pragma unroll
        for (int rb = 0; rb < 8; ++rb) gw[rb] = *(const u32x2*)(Z + (size_t)(TP + rb * 16 + fr) * INW + 6144 + j * 2048 + col);
        skinny_k<1, 4>(acc, A0, 1024, B0, 0, 4);
#pragma unroll
        for (int rb = 0; rb < 8; ++rb) { m[rb][0] += sigmoidf_(bf_lo(gw[rb].x)) * acc[0][rb][0]; m[rb][1] += sigmoidf_(bf_hi(gw[rb].x)) * acc[0][rb][1];
            m[rb][2] += sigmoidf_(bf_lo(gw[rb].y)) * acc[0][rb][2]; m[rb][3] += sigmoidf_(bf_hi(gw[rb].y)) * acc[0][rb][3]; }
    }
    const f32x4 v = xwave_reduce(lds, m, w, lane);
    u32x2 o; o.x = cvt_pk_bf16(v[0], v[1]); o.y = cvt_pk_bf16(v[2], v[3]); *(u32x2*)((bf16_t*)(p.ws + W_MB) + (size_t)(TP + 16 * w + fr) * DM + col) = o;
}
__device__ void s68_plain(const Params& p, int ti, size_t wA, size_t wB, float* outF, bf16_t* outB, float* lds) {
    const int w = threadIdx.x >> 6, lane = threadIdx.x & 63, fr = lane & 15, fq = lane >> 4, n0 = ti * 16, col = n0 + 4 * fq, kw0 = w * 256;
    const bf16_t* A0 = (const bf16_t*)(p.ws + wA) + (size_t)(TP + fr) * DM + fq * 8 + kw0; const bf16_t* B0 = (const bf16_t*)(p.ws + wB) + (size_t)(n0 + fr) * DM + fq * 8 + kw0;
    f32x4 acc[1][8];
#pragma unroll
    for (int rb = 0; rb < 8; ++rb) acc[0][rb] = (f32x4){0.f, 0.f, 0.f, 0.f};
    skinny_k<1, 4>(acc, A0, DM, B0, 0, 8);
    const f32x4 v = xwave_reduce(lds, acc[0], w, lane); const int row = TP + 16 * w + fr;
    if (outF) *(f32x4*)(outF + (size_t)row * DM + col) = v;
    else { u32x2 o; o.x = cvt_pk_bf16(v[0], v[1]); o.y = cvt_pk_bf16(v[2], v[3]); *(u32x2*)(outB + (size_t)row * DM + col) = o; }
}
__device__ void s9_scores(const Params& p, int ti) {
    const int w = threadIdx.x >> 6, lane = threadIdx.x & 63, fr = lane & 15, fq = lane >> 4, row = TP + 16 * w + fr, h = ti >> 3, nbp = ti & 7;
    const bf16_t* A = (const bf16_t*)(p.ws + W_QP) + (size_t)row * DM + h * 256 + fq * 8; const bf16_t* B = (const bf16_t*)(p.ws + W_WKT) + (size_t)(h * 256 + nbp * 32 + fr) * 256 + fq * 8;
    f32x4 acc[2] = {{0.f, 0.f, 0.f, 0.f}, {0.f, 0.f, 0.f, 0.f}};
    skinny_acc<2>(acc, A, B, (size_t)16 * 256, 256);
    float* SC = (float*)(p.ws + W_SC) + (size_t)row * DM + h * 256 + nbp * 32 + 4 * fq;
    *(f32x4*)SC = acc[0]; *(f32x4*)(SC + 16) = acc[1];
}

__device__ void p4a(const Params& p) {
    const float* SA = (const float*)(p.ws + W_SA); const float* SU = (const float*)(p.ws + W_SU); float* CA = (float*)(p.ws + W_CHK); float* CH = CA + 4 * 32 * 1024;
    for (int idx = blockIdx.x * 512 + threadIdx.x; idx < 4 * 32 * 1024; idx += gridDim.x * 512) {
        const int ch = idx & 1023, chunk = (idx >> 10) & 31, b = idx >> 15; const size_t base = ((size_t)b * 2048 + chunk * 64) * 1024 + ch;
        float A = 1.f, H = 0.f;
#pragma unroll 8
        for (int s = 0; s < 64; ++s) { const float a = SA[base + (size_t)s * 1024], u = SU[base + (size_t)s * 1024]; H = a * H + u; A *= a; }
        CA[idx] = A; CH[idx] = H;
    }
}
__device__ void p4b(const Params& p) {
    const float* __restrict__ SA = (const float*)(p.ws + W_SA); const float* __restrict__ SU = (const float*)(p.ws + W_SU); const float* __restrict__ CA = (const float*)(p.ws + W_CHK); const float* __restrict__ CH = CA + 4 * 32 * 1024;
    const bf16_t* __restrict__ Z = (const bf16_t*)(p.ws + W_Z); bf16_t* __restrict__ Y1 = (bf16_t*)(p.ws + W_YCAT) + (size_t)TPAD * 1024;
    const int nprompt = 4 * 32 * 1024, ntot = nprompt + TS * 1024;
    for (int idx = blockIdx.x * 512 + threadIdx.x; idx < ntot; idx += gridDim.x * 512) {
        if (idx < nprompt) {
            const int ch = idx & 1023, chunk = (idx >> 10) & 31, b = idx >> 15;
            float h = 0.f;
#pragma unroll 1
            for (int j0 = 0; j0 < chunk; j0 += 8) {
                float ca[8], chh[8];
#pragma unroll
                for (int e = 0; e < 8; ++e) { const int jj = min(j0 + e, 31), q = ((b * 32 + jj) << 10) + ch; ca[e] = CA[q]; chh[e] = CH[q]; }
#pragma unroll
                for (int e = 0; e < 8; ++e) if (j0 + e < chunk) h = ca[e] * h + chh[e];
            }
            const size_t t0 = (size_t)b * 2048 + chunk * 64;
#pragma unroll 1
            for (int s0 = 0; s0 < 64; s0 += 16) {
                float a[16], u[16], rg[16];
#pragma unroll
                for (int s = 0; s < 16; ++s) { const size_t t = t0 + s0 + s; a[s] = SA[t * 1024 + ch]; u[s] = SU[t * 1024 + ch]; rg[s] = bf1(Z[t * INW + 4096 + ch]); }
#pragma unroll
                for (int s = 0; s < 16; ++s) { h = a[s] * h + u[s]; Y1[(t0 + s0 + s) * 1024 + ch] = f2bf(h * gelu_tanh(rg[s])); }
            }
            if (chunk == 31) p.out[O_HP + (size_t)b * 1024 + ch] = h;
        } else {
            const int j = idx - nprompt, ch = j & 1023, bs = j >> 10; const size_t t = TP + bs;
            const float h = SA[t * 1024 + ch] * p.in[7][(size_t)bs * 1024 + ch] + SU[t * 1024 + ch];
            p.out[O_HS + (size_t)bs * 1024 + ch] = h;
            const float rg = bf1(Z[t * INW + 4096 + ch]); Y1[t * 1024 + ch] = f2bf(h * gelu_tanh(rg));
        }
    }
}


__device__ void p4a_tile(const Params& p, int pm, int h) {
    const float* SA = (const float*)(p.ws + W_SA); const float* SU = (const float*)(p.ws + W_SU); float* CA = (float*)(p.ws + W_CHK); float* CH = CA + 4 * 32 * 1024;
    const int ch = h * 128 + (threadIdx.x & 127), row0 = pm * 256 + (threadIdx.x >> 7) * 64, b = row0 >> 11, chunk = (row0 & 2047) >> 6;
    const size_t base = (size_t)row0 * 1024 + ch;
    float A = 1.f, H = 0.f;
#pragma unroll 1
    for (int s0 = 0; s0 < 64; s0 += 16) { float a[16], u[16];
#pragma unroll
        for (int s2 = 0; s2 < 16; ++s2) { a[s2] = SA[base + (size_t)(s0 + s2) * 1024]; u[s2] = SU[base + (size_t)(s0 + s2) * 1024]; }
#pragma unroll
        for (int s2 = 0; s2 < 16; ++s2) { H = a[s2] * H + u[s2]; A *= a[s2]; } }
    const int idx = ((b * 32 + chunk) << 10) + ch; CA[idx] = A; CH[idx] = H;
}
__device__ void s9_full(const Params& p, int h) {
    const int w = threadIdx.x >> 6, lane = threadIdx.x & 63, fr = lane & 15, fq = lane >> 4, row = TP + 16 * w + fr;
    const bf16_t* A = (const bf16_t*)(p.ws + W_QP) + (size_t)row * DM + h * 256 + fq * 8; float* SC = (float*)(p.ws + W_SC) + (size_t)row * DM + h * 256 + 4 * fq;
#pragma unroll 1
    for (int g4 = 0; g4 < 4; ++g4) {
        const bf16_t* B = (const bf16_t*)(p.ws + W_WKT) + (size_t)(h * 256 + g4 * 64 + fr) * 256 + fq * 8;
        f32x4 acc[4] = {{0.f, 0.f, 0.f, 0.f}, {0.f, 0.f, 0.f, 0.f}, {0.f, 0.f, 0.f, 0.f}, {0.f, 0.f, 0.f, 0.f}};
        skinny_acc<4>(acc, A, B, (size_t)16 * 256, 256);
#pragma unroll
        for (int nb = 0; nb < 4; ++nb) *(f32x4*)(SC + g4 * 64 + nb * 16) = acc[nb];
    }
}

__device__ void p7(const Params& p, float* lds) {
    const float* H1 = (const float*)(p.ws + W_H1); bf16_t* X1B = (bf16_t*)(p.ws + W_X1B);
    const int lane = threadIdx.x & 63, w = threadIdx.x >> 6, gw = blockIdx.x * 8 + w, nw = gridDim.x * 8;
    for (int row = gw; row < TP; row += nw) {
        f32x4 v[8]; float s = 0.f; const float* xrow = p.in[0] + (size_t)row * DM;
#pragma unroll
        for (int j = 0; j < 8; ++j) { v[j] = *(const f32x4*)(H1 + (size_t)row * DM + j * 256 + lane * 4) + *(const f32x4*)(xrow + j * 256 + lane * 4) * DN_ALPHA; s += v[j][0] + v[j][1] + v[j][2] + v[j][3]; }
        const float mean = wave_sum(s) * (1.0f / DM); float q = 0.f;
#pragma unroll
        for (int j = 0; j < 8; ++j) { v[j] -= mean; q += v[j][0] * v[j][0] + v[j][1] * v[j][1] + v[j][2] * v[j][2] + v[j][3] * v[j][3]; }
        const float rstd = rsqrtf(wave_sum(q) * (1.0f / DM) + LN_EPS);
#pragma unroll
        for (int j = 0; j < 8; ++j) { const int c = j * 256 + lane * 4; const f32x4 g = *(const f32x4*)(p.in[23] + c), bb = *(const f32x4*)(p.in[24] + c);
            const f32x4 y = v[j] * rstd * g + bb;
            u32x2 wd; wd.x = cvt_pk_bf16(y[0], y[1]); wd.y = cvt_pk_bf16(y[2], y[3]); *(u32x2*)(X1B + (size_t)row * DM + c) = wd; }
    }
    for (int r = blockIdx.x; r < TS; r += gridDim.x) {
        const int row = TP + r, c = w * 256 + lane * 4;
        f32x4 v = *(const f32x4*)(H1 + (size_t)row * DM + c) + *(const f32x4*)(p.in[1] + (size_t)r * DM + c) * DN_ALPHA;
        const float s = wave_sum(v[0] + v[1] + v[2] + v[3]);
        __syncthreads();
        if (lane == 0) lds[w] = s;
        __syncthreads();
        float tot = 0.f;
#pragma unroll
        for (int ww = 0; ww < 8; ++ww) tot += lds[ww];
        v -= tot * (1.0f / DM);
        const float q = wave_sum(v[0] * v[0] + v[1] * v[1] + v[2] * v[2] + v[3] * v[3]);
        if (lane == 0) lds[8 + w] = q;
        __syncthreads();
        float qt = 0.f;
#pragma unroll
        for (int ww = 0; ww < 8; ++ww) qt += lds[8 + ww];
        const float rstd = rsqrtf(qt * (1.0f / DM) + LN_EPS);
        const f32x4 g = *(const f32x4*)(p.in[23] + c), bb = *(const f32x4*)(p.in[24] + c); const f32x4 y = v * rstd * g + bb;
        u32x2 wd; wd.x = cvt_pk_bf16(y[0], y[1]); wd.y = cvt_pk_bf16(y[2], y[3]); *(u32x2*)(X1B + (size_t)row * DM + c) = wd;
    }
}

__device__ __forceinline__ unsigned ord_key(float f) { const unsigned u = __float_as_uint(f); return (u & 0x80000000u) ? ~u : (u | 0x80000000u); }
__device__ __forceinline__ float ord_val(unsigned k) { return __uint_as_float((k & 0x80000000u) ? (k & 0x7fffffffu) : ~k); }

#define CE_DESC(a, b) do { const unsigned mx_ = max(a, b), mn_ = min(a, b); a = mx_; b = mn_; } while (0)
__device__ void p9b(const Params& p, int mode) {
    const float* SC = (const float*)(p.ws + W_SC); u32x4* PICKS = (u32x4*)(p.ws + W_PICKS); const float* SCU = (const float*)(p.ws + W_SCU); const float* SCV = (const float*)(p.ws + W_SCV);
    const int nitem = TT * 16, gid = blockIdx.x * 512 + threadIdx.x, gth = gridDim.x * 512;
    int pm1 = 0, h1 = 0; if (mode == 1) std_tile((int)blockIdx.x, 32, 8, pm1, h1);
    const bool fast = (mode == 0 && gth == TP * 16);
    const int npass = (mode == 1 || fast) ? 2 : (nitem + gth - 1) / gth;
#pragma unroll 1
    for (int pass_ = 0; pass_ < npass; ++pass_) {
        int item = gid + pass_ * gth;
        if (mode == 1) { const int tt = pass_ == 0 ? pm1 * 256 + (int)(threadIdx.x >> 1) : TP + (int)(threadIdx.x >> 1), hh = pass_ == 0 ? h1 : (int)blockIdx.x;
            item = (pass_ == 0 || (blockIdx.x < 8 && threadIdx.x < 256)) ? ((tt * 8 + hh) << 1) + (int)(threadIdx.x & 1) : nitem; }
        if (fast && pass_ == 1) item = (threadIdx.x < 64 && blockIdx.x < 32) ? TP * 16 + (int)blockIdx.x * 64 + (int)threadIdx.x : nitem;
        if (item >= nitem) continue;
        const int c = item & 1, th = item >> 1, t = th >> 3, h = th & 7;
        const float* sp = SC + (size_t)t * DM + h * 256 + c * 128;
        unsigned key[128];
#pragma unroll
        for (int i = 0; i < 32; ++i) { const f32x4 v = *(const f32x4*)(sp + i * 4);
#pragma unroll
            for (int e = 0; e < 4; ++e) key[i * 4 + e] = (ord_key(v[e]) & 0xffffff80u) | (unsigned)(127 - (i * 4 + e)); }
#pragma unroll
        for (int gq = 0; gq < 8; ++gq)
#pragma unroll
            for (int k = 2; k <= 16; k <<= 1)
#pragma unroll
                for (int j = k >> 1; j > 0; j >>= 1)
#pragma unroll
                    for (int i = 0; i < 16; ++i) { const int l = i ^ j; if (l > i) { if ((i & k) == 0) CE_DESC(key[gq * 16 + i], key[gq * 16 + l]); else CE_DESC(key[gq * 16 + l], key[gq * 16 + i]); } }
#pragma unroll
        for (int span = 1; span < 8; span <<= 1)
#pragma unroll
            for (int gq = 0; gq < 8; gq += 2 * span) {
#pragma unroll
                for (int i = 0; i < 16; ++i) key[gq * 16 + i] = max(key[gq * 16 + i], key[(gq + span) * 16 + 15 - i]);
#pragma unroll
                for (int j = 8; j > 0; j >>= 1)
#pragma unroll
                    for (int i = 0; i < 16; ++i) { const int l = i ^ j; if (l > i) CE_DESC(key[gq * 16 + i], key[gq * 16 + l]); }
            }
        unsigned top[16];
#pragma unroll
        for (int q = 0; q < 16; ++q) top[q] = key[q];
        float sm[16], so[16]; int im[16], io[16];
#pragma unroll
        for (int q = 0; q < 16; ++q) { sm[q] = ord_val(top[q] & 0xffffff80u); im[q] = 127 - (int)(top[q] & 127u); so[q] = __shfl_xor(sm[q], 1, 64); io[q] = __shfl_xor(im[q], 1, 64); }
        float s1[16], s2[16]; int i1[16], i2[16];
#pragma unroll
        for (int q = 0; q < 16; ++q) { s1[q] = c ? so[q] : sm[q]; s2[q] = c ? sm[q] : so[q]; i1[q] = c ? io[q] : im[q]; i2[q] = c ? im[q] : io[q]; }
        unsigned ck[50]; int nc = 0;
#pragma unroll
        for (int i = 0; i < 16; ++i)
#pragma unroll
            for (int j = 0; j < 16; ++j) if ((i + 1) * (j + 1) <= 16) { ck[nc] = (ord_key(s1[i] + s2[j]) & 0xffffff00u) | (unsigned)(255 - (i * 16 + j)); ++nc; }
        unsigned c64[64];
#pragma unroll
        for (int i = 0; i < 64; ++i) c64[i] = (i < 50) ? ck[i] : 0u;
#pragma unroll
        for (int gq = 0; gq < 4; ++gq)
#pragma unroll
            for (int k = 2; k <= 16; k <<= 1)
#pragma unroll
                for (int j = k >> 1; j > 0; j >>= 1)
#pragma unroll
                    for (int i = 0; i < 16; ++i) { const int l = i ^ j; if (l > i) { if ((i & k) == 0) CE_DESC(c64[gq * 16 + i], c64[gq * 16 + l]); else CE_DESC(c64[gq * 16 + l], c64[gq * 16 + i]); } }
#pragma unroll
        for (int span = 1; span < 4; span <<= 1)
#pragma unroll
            for (int gq = 0; gq < 4; gq += 2 * span) {
#pragma unroll
                for (int i = 0; i < 16; ++i) c64[gq * 16 + i] = max(c64[gq * 16 + i], c64[(gq + span) * 16 + 15 - i]);
#pragma unroll
                for (int j = 8; j > 0; j >>= 1)
#pragma unroll
                    for (int i = 0; i < 16; ++i) { const int l = i ^ j; if (l > i) CE_DESC(c64[gq * 16 + i], c64[gq * 16 + l]); }
            }
        unsigned ct[16];
#pragma unroll
        for (int q = 0; q < 16; ++q) ct[q] = c64[q];
        const float vmax = ord_val(ct[0] & 0xffffff00u); float ev[16], esum = 0.f;
#pragma unroll
        for (int q = 0; q < 16; ++q) { ev[q] = fast_exp(ord_val(ct[q] & 0xffffff00u) - vmax); esum += ev[q]; }
        const float einv = 1.0f / esum;
#pragma unroll
        for (int q = 0; q < 8; ++q) {
            const unsigned cm = (unsigned)(-c);
            const unsigned kk = ct[2 * q] ^ ((ct[2 * q] ^ ct[2 * q + 1]) & cm);
            const unsigned eb0 = __float_as_uint(ev[2 * q]), eb1 = __float_as_uint(ev[2 * q + 1]);
            const float gwt = __uint_as_float(eb0 ^ ((eb0 ^ eb1) & cm)) * einv;
            const int cid = 255 - (int)(kk & 255u), ci = cid >> 4, cj = cid & 15;
            int e1 = 0, e2 = 0;
#pragma unroll
            for (int r = 0; r < 16; ++r) { e1 = (ci == r) ? i1[r] : e1; e2 = (cj == r) ? i2[r] : e2; }
            const int ex = e1 * 128 + e2;
            u32x4 pk; pk.x = (unsigned)ex; pk.y = __float_as_uint(gwt * SCV[ex]); pk.z = __float_as_uint(SCU[ex]); pk.w = 0u;
            PICKS[(size_t)t * 128 + h * 16 + 2 * q + c] = pk;
        }
    }
}

__device__ void p10(const Params& p, float* lds) {
    const bf16_t* X1B = (const bf16_t*)(p.ws + W_X1B); const u32x4* PICKS = (const u32x4*)(p.ws + W_PICKS);
    const unsigned char* U8 = p.ws + W_UB; const unsigned char* V8 = p.ws + W_VB;
    const int w = threadIdx.x >> 6, lane = threadIdx.x & 63;
    for (int t = blockIdx.x; t < TT; t += gridDim.x) {
        f32x2 xe[2][8];
#pragma unroll
        for (int j = 0; j < 2; ++j)
#pragma unroll
            for (int q = 0; q < 2; ++q) { const u32x4 v = *(const u32x4*)(X1B + (size_t)t * DM + j * 1024 + lane * 16 + q * 8);
                xe[j][4 * q] = (f32x2){bf_lo(v.x), bf_hi(v.x)}; xe[j][4 * q + 1] = (f32x2){bf_lo(v.y), bf_hi(v.y)}; xe[j][4 * q + 2] = (f32x2){bf_lo(v.z), bf_hi(v.z)}; xe[j][4 * q + 3] = (f32x2){bf_lo(v.w), bf_hi(v.w)}; }
        const u32x4 mypick = PICKS[(size_t)t * 128 + w * 16 + (lane & 15)];
        f32x2 y[2][8];
#pragma unroll
        for (int j = 0; j < 2; ++j)
#pragma unroll
            for (int e = 0; e < 8; ++e) y[j][e] = (f32x2){0.f, 0.f};
#pragma unroll 1
        for (int k = 0; k < 16; k += 8) {
            u32x4 uw[8][2], vw[8][2]; float cvv[8], suu[8];
#pragma unroll
            for (int g = 0; g < 8; ++g) {
                const unsigned e = (unsigned)__builtin_amdgcn_readlane((int)mypick.x, k + g) & 16383u;
                cvv[g] = __uint_as_float((unsigned)__builtin_amdgcn_readlane((int)mypick.y, k + g)); suu[g] = __uint_as_float((unsigned)__builtin_amdgcn_readlane((int)mypick.z, k + g));
                const unsigned char* up = U8 + (size_t)e * 2048 + lane * 16; const unsigned char* vp = V8 + (size_t)e * 2048 + lane * 16;
                uw[g][0] = *(const u32x4*)up; uw[g][1] = *(const u32x4*)(up + 1024); vw[g][0] = *(const u32x4*)vp; vw[g][1] = *(const u32x4*)(vp + 1024);
            }
#pragma unroll
            for (int g = 0; g < 8; ++g) {
                f32x2 d2 = (f32x2){0.f, 0.f};
#pragma unroll
                for (int j = 0; j < 2; ++j)
#pragma unroll
                    for (int q = 0; q < 4; ++q) { const int wd = (int)uw[g][j][q];
                        d2 += __builtin_amdgcn_cvt_pk_f32_fp8(wd, false) * xe[j][2 * q]; d2 += __builtin_amdgcn_cvt_pk_f32_fp8(wd, true) * xe[j][2 * q + 1]; }
                const float d = wave_sum(d2[0] + d2[1]);
                const float cf = cvv[g] * gelu_tanh(d * suu[g]);
#pragma unroll
                for (int j = 0; j < 2; ++j)
#pragma unroll
                    for (int q = 0; q < 4; ++q) { const int wd = (int)vw[g][j][q];
                        y[j][2 * q] += __builtin_amdgcn_cvt_pk_f32_fp8(wd, false) * cf; y[j][2 * q + 1] += __builtin_amdgcn_cvt_pk_f32_fp8(wd, true) * cf; }
            }
        }
#pragma unroll
        for (int j = 0; j < 2; ++j)
#pragma unroll
            for (int q = 0; q < 4; ++q) *(f32x4*)(lds + w * 2048 + j * 1024 + lane * 16 + q * 4) = (f32x4){y[j][2 * q][0], y[j][2 * q][1], y[j][2 * q + 1][0], y[j][2 * q + 1][1]};
        __syncthreads();
        {
            const int c0 = threadIdx.x * 4; f32x4 acc = *(const f32x4*)(lds + c0);
#pragma unroll
            for (int ww = 1; ww < 8; ++ww) acc += *(const f32x4*)(lds + ww * 2048 + c0);
            const u32x2 xw = *(const u32x2*)(X1B + (size_t)t * DM + c0); const f32x4 xv = (f32x4){bf_lo(xw.x), bf_hi(xw.x), bf_lo(xw.y), bf_hi(xw.y)};
            f32x4 r = xv * DN_ALPHA + acc;
            float s = wave_sum(r[0] + r[1] + r[2] + r[3]);
            if (lane == 0) lds[16384 + w] = s;
            __syncthreads();
            float tot = 0.f;
#pragma unroll
            for (int ww = 0; ww < 8; ++ww) tot += lds[16384 + ww];
            const float mean = tot * (1.0f / DM); r -= mean;
            float q = wave_sum(r[0] * r[0] + r[1] * r[1] + r[2] * r[2] + r[3] * r[3]);
            if (lane == 0) lds[16400 + w] = q;
            __syncthreads();
            float qt = 0.f;
#pragma unroll
            for (int ww = 0; ww < 8; ++ww) qt += lds[16400 + ww];
            const float rstd = rsqrtf(qt * (1.0f / DM) + LN_EPS);
            const f32x4 g = *(const f32x4*)(p.in[29] + c0), bb = *(const f32x4*)(p.in[30] + c0);
            *(f32x4*)(p.out + O_Y + (size_t)t * DM + c0) = r * rstd * g + bb;
        }
        __syncthreads();
    }
}


#ifdef DBG_DUMP
__device__ void dbg_dump(const Params& p) {
    const bf16_t* src = (const bf16_t*)(p.ws + DBG_DUMP_OFF);
    for (size_t i = (size_t)blockIdx.x * 512 + threadIdx.x; i < (size_t)TT * 1024; i += (size_t)gridDim.x * 512) {
        if (DBG_LAST <= 2 && i < 19947520 - O_CZP) p.out[O_CZP + i] = 0.f;
        const size_t r = i >> 10, c = i & 1023; p.out[O_Y + r * DM + c] = (r < TP) ? bf1(src[r * DBG_DUMP_LD + c]) : 0.f; p.out[O_Y + r * DM + 1024 + c] = 0.f; }
}
#endif

__device__ __forceinline__ void grid_bar(unsigned* words, unsigned n) {
    asm volatile("s_waitcnt vmcnt(0) lgkmcnt(0)" ::: "memory");
    __syncthreads();
    if (threadIdx.x == 0) {
        const unsigned G = gridDim.x, grp = blockIdx.x & 7u, gs = (G - grp + 7u) >> 3, ngrp = G < 8u ? G : 8u;
        __builtin_amdgcn_fence(__ATOMIC_RELEASE, "agent");
        const unsigned old = __hip_atomic_fetch_add(words + 32 * (1 + grp), 1u, __ATOMIC_RELAXED, __HIP_MEMORY_SCOPE_AGENT);
        if (old + 1u == n * gs) __hip_atomic_fetch_add(words, 1u, __ATOMIC_RELAXED, __HIP_MEMORY_SCOPE_AGENT);
        while (__hip_atomic_load(words, __ATOMIC_RELAXED, __HIP_MEMORY_SCOPE_AGENT) < n * ngrp) __builtin_amdgcn_s_sleep(1);
        __builtin_amdgcn_fence(__ATOMIC_ACQUIRE, "agent");
        asm volatile("s_waitcnt vmcnt(0)" ::: "memory");
    }
    __syncthreads();
}
extern __shared__ __attribute__((aligned(16))) unsigned char smem_raw[];

__global__ void __launch_bounds__(512, 2) fwd_kernel(Params p) {
    LAS unsigned char* lds = (LAS unsigned char*)smem_raw;
    float* ldsf = (float*)smem_raw;
    unsigned char* ws = p.ws;
    const int G = gridDim.x, c = blockIdx.x;
#ifndef ONLY_PH
#define ONLY_PH -1
#endif
    unsigned* barw = (unsigned*)(ws + W_BAR); unsigned nbar = 0;
#define UCONV(R0, R1) if (c >= G / 2) cvt_fp8_rows(p.in[27] + (size_t)(R0) * 2048, ws + W_UB + (size_t)(R0) * 2048, (float*)(ws + W_SCU) + (R0), (R1) - (R0), (c - G / 2) * 8 + (int)(threadIdx.x >> 6), (G - G / 2) * 8)
#define RUNPH_NB(n, ...) if ((ONLY_PH < 0 || ONLY_PH == (n)) && p.ph_lo <= (n) && (n) < p.ph_hi) { __VA_ARGS__; }
#define RUNPH(n, ...) if ((ONLY_PH < 0 || ONLY_PH == (n)) && p.ph_lo <= (n) && (n) < p.ph_hi) { __VA_ARGS__; if ((n) + 1 < p.ph_hi) { ++nbar; grid_bar(barw, nbar); } }
    RUNPH(0, phase0(p, ldsf))
    RUNPH(1, { Gemm g{(const bf16_t*)(ws + W_AALL), (const bf16_t*)(ws + W_BTALL), 2048, 2048, 2048};
            Epi1 e{(bf16_t*)(ws + W_Z), p.out + O_MK, p.out + O_MV, (bf16_t*)(ws + W_MKB), (bf16_t*)(ws + W_VTB)};
            SchedGrid s{32, 48, G, c, 0}; gemm_phase(lds, g, s, e);
            for (int ti = c; ti < 256; ti += G) s1_zin(p, ti, ldsf); })
    RUNPH(2, { const int nmk = G > 64 ? 32 : 0;
            if (c < nmk || nmk == 0) { Gemm g{(const bf16_t*)(ws + W_AALL), (const bf16_t*)(ws + W_BTALL), 2048, 2048, 2048};
                Epi1 e{(bf16_t*)(ws + W_Z), p.out + O_MK, p.out + O_MV, (bf16_t*)(ws + W_MKB), (bf16_t*)(ws + W_VTB)};
                SchedMKV s{nmk ? nmk : G, c}; gemm_phase(lds, g, s, e); }
            if (c >= nmk) for (int it = c - nmk; it < 672; it += G - nmk) {
                if (it < 512) p2_attn_sample(p, it, ldsf);
                else if (it < 640) p2_elem_prompt(p, it - 512);
                else p2_elem_sample(p, it - 640);
            }
            if (c >= nmk) cvt_fp8_rows(p.in[28], ws + W_VB, (float*)(ws + W_SCV), 16384, (c - nmk) * 8 + (int)(threadIdx.x >> 6), (G - nmk) * 8); })
    RUNPH(3, { Gemm g{(const bf16_t*)(ws + W_XR), (const bf16_t*)(ws + W_WGT), 1024, 256, 256};
            Epi3 e{(const bf16_t*)(ws + W_XR), (float*)(ws + W_SA), (float*)(ws + W_SU), p.in[13], p.in[15], p.in[16]};
            SchedGrid s{32, 8, G, c, 1}; gemm_phase(lds, g, s, e);
            for (int ti = c; ti < 64; ti += G) s3_gates(p, ti);
            if (G == 256) { int pm_, pn_; std_tile(c, 32, 8, pm_, pn_); asm volatile("s_waitcnt vmcnt(0)" ::: "memory"); __syncthreads(); p4a_tile(p, pm_, pn_); }
            for (int it = c; it < 256; it += G) p2_attn_prompt(p, it); })
    if (G != 256) { RUNPH(4, p4a(p)) }
    RUNPH(5, p4b(p))
    RUNPH(6, { Gemm g{(const bf16_t*)(ws + W_YCAT), (const bf16_t*)(ws + W_WBRT), 1024, 1024, 1024};
            Epi5 e{(const bf16_t*)(ws + W_Z), (bf16_t*)(ws + W_MF), (bf16_t*)(ws + W_MF) + (size_t)TPAD * DM, (bf16_t*)(ws + W_MB)};
            Sched5 s{G, c}; gemm_phase(lds, g, s, e);
            for (int ti = c; ti < 128; ti += G) s5_merge(p, ti, ldsf);
            UCONV(0, 5461); })
    RUNPH(7, { Gemm g{(const bf16_t*)(ws + W_MB), (const bf16_t*)(ws + W_WOT), 2048, 2048, 2048};
            EpiF e{(float*)(ws + W_H1), 2048};
            SchedGrid s{32, 8, G, c, 0}; gemm_phase(lds, g, s, e);
            for (int ti = c; ti < 128; ti += G) s68_plain(p, ti, W_MB, W_WOT, (float*)(ws + W_H1), nullptr, ldsf);
            UCONV(5461, 10922); })
    RUNPH(8, p7(p, ldsf))
    RUNPH(9, { Gemm g{(const bf16_t*)(ws + W_X1B), (const bf16_t*)(ws + W_WQT), 2048, 2048, 2048};
            EpiB e{(bf16_t*)(ws + W_QP), 2048};
            SchedGrid s{32, 8, G, c, 0}; gemm_phase(lds, g, s, e);
            for (int ti = c; ti < 128; ti += G) s68_plain(p, ti, W_X1B, W_WQT, nullptr, (bf16_t*)(ws + W_QP), ldsf);
            UCONV(10922, 16384); })
    RUNPH_NB(10, { Gemm g{(const bf16_t*)(ws + W_QP), (const bf16_t*)(ws + W_WKT), 2048, 256, 256};
            EpiF e{(float*)(ws + W_SC), 2048};
            SchedGrid s{32, 8, G, c, 2}; gemm_phase(lds, g, s, e);
            for (int ti = c; ti < 64; ti += G) s9_scores(p, ti); })
    if (p.ph_lo <= 10 && 11 < p.ph_hi) { ++nbar; grid_bar(barw, nbar); }
    RUNPH(11, p9b(p, 0))
    RUNPH(12, p10(p, ldsf))
    if (p.ph_hi > 4096) cg::this_grid().sync();
#ifdef DBG_DUMP
    RUNPH(13, dbg_dump(p))
#endif
}

#ifndef N_LAUNCH_PER_PHASE
#define N_LAUNCH_PER_PHASE 0
#endif

extern "C" void kernel_launch(void* const* d_in, const int* in_sizes, int n_in, void* d_out, int out_size, void* d_ws, size_t ws_size, hipStream_t stream) {
    constexpr int LDS_BYTES = STAGE_BYTES;
    static int grid = 0;
    if (grid == 0) {
        if (n_in != 31 || ws_size < W_END) { fprintf(stderr, "kernel_launch: unexpected n_in %d / ws_size %zu (need %zu)\n", n_in, ws_size, (size_t)W_END); grid = -1; return; }
        int dev = 0, cus = 0, per_cu = 0;
        hipGetDevice(&dev); hipDeviceGetAttribute(&cus, hipDeviceAttributeMultiprocessorCount, dev);
        if (hipFuncSetAttribute((const void*)fwd_kernel, hipFuncAttributeMaxDynamicSharedMemorySize, LDS_BYTES) != hipSuccess) { fprintf(stderr, "hipFuncSetAttribute failed\n"); grid = -1; return; }
        if (hipOccupancyMaxActiveBlocksPerMultiprocessor(&per_cu, (const void*)fwd_kernel, 512, LDS_BYTES) != hipSuccess || per_cu < 1) { fprintf(stderr, "occupancy query failed (%d)\n", per_cu); per_cu = 1; }
        (void)hipGetLastError();
        grid = cus * (per_cu > 1 ? 1 : per_cu);
    }
    if (grid < 0) return;
    Params p{};
    for (int i = 0; i < 31; ++i) p.in[i] = (const float*)d_in[i];
    p.out = (float*)d_out; p.ws = (unsigned char*)d_ws;
#if N_LAUNCH_PER_PHASE
    #ifdef DBG_DUMP
    for (int ph = 0; ph < DBG_LAST; ++ph) { p.ph_lo = ph; p.ph_hi = ph + 1; hipLaunchKernelGGL(fwd_kernel, dim3(grid), dim3(512), LDS_BYTES, stream, p); }
    p.ph_lo = 13; p.ph_hi = 14; hipLaunchKernelGGL(fwd_kernel, dim3(grid), dim3(512), LDS_BYTES, stream, p);
#else
    for (int ph = 0; ph < NPH; ++ph) { p.ph_lo = ph; p.ph_hi = ph + 1; hipLaunchKernelGGL(fwd_kernel, dim3(grid), dim3(512), LDS_BYTES, stream, p); }
#endif
#else
    p.ph_lo = 0; p.ph_hi = NPH;
    (void)hipMemsetAsync((char*)d_ws + W_BAR, 0, 2048, stream);
    void* args[] = {&p};
    hipError_t e = hipLaunchCooperativeKernel((const void*)fwd_kernel, dim3(grid), dim3(512), args, LDS_BYTES, stream);
    if (e != hipSuccess) fprintf(stderr, "cooperative launch failed: %s (grid %d)\n", hipGetErrorString(e), grid);
#endif
}
```

```cpp
#define DBG_DUMP_OFF (W_YCAT + (size_t)2 * TPAD * 1024 * 2)
#define DBG_DUMP_LD 1024
#define DBG_LAST 6
#define REPMASK 0
#include <hip/hip_runtime.h>
#include <hip/hip_cooperative_groups.h>
#include <cstdio>
namespace cg = cooperative_groups;

#define LAS __attribute__((address_space(3)))
typedef unsigned short bf16_t;
typedef short bf16x8 __attribute__((ext_vector_type(8)));
typedef float f32x4 __attribute__((ext_vector_type(4)));
typedef float f32x2 __attribute__((ext_vector_type(2)));
typedef unsigned u32x4 __attribute__((ext_vector_type(4)));
typedef unsigned u32x2 __attribute__((ext_vector_type(2)));

constexpr int DM = 2048, TP = 8192, TS = 128, TT = 8320, TPAD = 8448, NMEM = 1024, INW = 12288;
constexpr int NPH = 13;
constexpr float DN_ALPHA = 1.189207115002721f;
constexpr float LN_EPS = 1e-5f;
constexpr size_t O_Y = 0, O_MK = 17039360, O_MV = 18087936, O_CZP = 19136512, O_RCP = 19144704, O_HP = 19156992,
                 O_CZS = 19161088, O_RCS = 19423232, O_HS = 19816448;
constexpr size_t al256(size_t x) { return (x + 255) & ~(size_t)255; }
constexpr size_t W_AALL = 0;
constexpr size_t W_BTALL = W_AALL + (size_t)9472 * 2048 * 2;
constexpr size_t W_WBRT = W_BTALL + (size_t)14336 * 2048 * 2;
constexpr size_t W_WOT = W_WBRT + (size_t)3 * 2048 * 1024 * 2;
constexpr size_t W_WQT = W_WOT + (size_t)2048 * 2048 * 2;
constexpr size_t W_WGT = W_WQT + (size_t)2048 * 2048 * 2;
constexpr size_t W_WKT = W_WGT + (size_t)2048 * 256 * 2;
constexpr size_t W_UB = W_WKT + (size_t)2048 * 256 * 2;
constexpr size_t W_VB = W_UB + (size_t)16384 * 2048 * 2;
constexpr size_t W_Z = W_VB + (size_t)16384 * 2048 * 2;
constexpr size_t W_MKB = W_Z + (size_t)TPAD * INW * 2;
constexpr size_t W_VTB = W_MKB + (size_t)1024 * 1024 * 2;
constexpr size_t W_YCAT = W_VTB + (size_t)1024 * 1024 * 2;
constexpr size_t W_XR = W_YCAT + (size_t)3 * TPAD * 1024 * 2;
constexpr size_t W_SA = W_XR + (size_t)TPAD * 1024 * 2;
constexpr size_t W_SU = W_SA + (size_t)TPAD * 1024 * 4;
constexpr size_t W_CHK = W_SU + (size_t)TPAD * 1024 * 4;
constexpr size_t W_MF = W_CHK + (size_t)2 * 4 * 32 * 1024 * 4;
constexpr size_t W_MB = W_MF + (size_t)TPAD * DM * 4;
constexpr size_t W_SCU = W_MB + (size_t)TPAD * DM * 2;
constexpr size_t W_SCV = W_SCU + 16384 * 4;
constexpr size_t W_BAR = W_SCV + 16384 * 4;
constexpr size_t W_END = W_BAR + 2048;
constexpr size_t W_H1 = W_Z;
constexpr size_t W_X1F = W_Z + (size_t)TPAD * DM * 4;
constexpr size_t W_X1B = W_X1F + (size_t)TPAD * DM * 4;
constexpr size_t W_QP = W_YCAT;
constexpr size_t W_SC = W_MF;
constexpr size_t W_PICKS = W_SA;
static_assert(W_X1B + (size_t)TPAD * DM * 2 <= W_MKB, "alias overflow");
static_assert((size_t)TPAD * DM * 2 <= (size_t)3 * TPAD * 1024 * 2, "alias overflow");

struct Params {
    const float* in[31];
    float* out;
    unsigned char* ws;
    int ph_lo, ph_hi;
};

typedef __bf16 bf16x2_t __attribute__((ext_vector_type(2)));
__device__ __forceinline__ unsigned cvt_pk_bf16(float lo, float hi) { const f32x2 v = {lo, hi}; return __builtin_bit_cast(unsigned, __builtin_convertvector(v, bf16x2_t)); }
__device__ __forceinline__ float bf_lo(unsigned w) { return __uint_as_float(w << 16); }
__device__ __forceinline__ float bf_hi(unsigned w) { return __uint_as_float(w & 0xffff0000u); }
__device__ __forceinline__ float bf1(bf16_t b) { return __uint_as_float(((unsigned)b) << 16); }
__device__ __forceinline__ bf16_t f2bf(float f) { return (bf16_t)(cvt_pk_bf16(f, 0.f) & 0xffffu); }
__device__ __forceinline__ void unpack8(u32x4 w, float* v) {
    v[0] = bf_lo(w.x); v[1] = bf_hi(w.x); v[2] = bf_lo(w.y); v[3] = bf_hi(w.y); v[4] = bf_lo(w.z); v[5] = bf_hi(w.z); v[6] = bf_lo(w.w); v[7] = bf_hi(w.w);
}
__device__ __forceinline__ u32x4 pack8(const float* v) {
    u32x4 w; w.x = cvt_pk_bf16(v[0], v[1]); w.y = cvt_pk_bf16(v[2], v[3]); w.z = cvt_pk_bf16(v[4], v[5]); w.w = cvt_pk_bf16(v[6], v[7]); return w;
}
__device__ __forceinline__ float fast_exp(float x) { return __builtin_amdgcn_exp2f(x * 1.4426950408889634f); }
__device__ __forceinline__ float sigmoidf_(float x) { return __builtin_amdgcn_rcpf(1.0f + fast_exp(-x)); }
__device__ __forceinline__ float gelu_tanh(float x) {
    const float z = 0.7978845608028654f * (x + 0.044715f * x * x * x);
    const float th = 1.0f - 2.0f * __builtin_amdgcn_rcpf(1.0f + fast_exp(2.0f * z));
    return 0.5f * x * (1.0f + th);
}
__device__ __forceinline__ int launder_tid() { int t = threadIdx.x; asm volatile("" : "+v"(t)); return t; }
__device__ __forceinline__ float wave_sum(float v) {
#pragma unroll
    for (int o = 32; o > 0; o >>= 1) v += __shfl_xor(v, o, 64);
    return v;
}

constexpr int BM = 256, BK = 64, HALF = 128, HTB = HALF * BK * 2, STAGE_BYTES = 8 * HTB, NXCD = 8, WGM = 4;
__device__ __forceinline__ int lds_byte(int r, int c) { const int st = (r >> 4) * 2 + (c >> 5), rr = r & 15, cc = c & 31, ob = rr * 64 + cc * 2; return st * 1024 + (ob ^ (((ob >> 9) & 1) << 5)); }
__device__ __forceinline__ void stage_rc(int b, int& R, int& C) { const int st = b / 1024, sb = b % 1024, swz = sb ^ (((sb >> 9) & 1) << 5); R = (st >> 1) * 16 + swz / 64; C = (st & 1) * 32 + (swz % 64) / 2; }
__device__ __forceinline__ int perm32(int rho) { const int n = rho >> 4, i = rho & 15; return 8 * (i >> 2) + 4 * n + (i & 3); }

struct Unit { int pm, pn, ka; };
struct Gemm { const bf16_t* A; const bf16_t* Bt; int lda, ldb, K; };

__device__ __forceinline__ void std_tile(int L, int nM, int nN, int& pm, int& pn) {
    const int nwg = nM * nN; int wgid = L;
    { const int q = nwg / NXCD, r = nwg % NXCD, xcd = wgid % NXCD, off = wgid / NXCD; wgid = (xcd < r ? xcd * (q + 1) : r * (q + 1) + (xcd - r) * q) + off; }
    const int nig = WGM * nN, gid = wgid / nig, fm = gid * WGM, gsz = (nM - fm) < WGM ? (nM - fm) : WGM;
    pm = fm + ((wgid % nig) % gsz); pn = (wgid % nig) / gsz;
}

template <class Epi, class Sched>
__device__ __forceinline__ void gemm_phase(LAS unsigned char* lds, const Gemm g, const Sched& S, const Epi& E) {
    const int tid = threadIdx.x, wid = __builtin_amdgcn_readfirstlane(tid >> 6), lane = tid & 63, wr = wid >> 2, wc = wid & 3, fr = lane & 15, fq = lane >> 4;
    const int K = g.K, nt = K / BK;
    unsigned voffA[2], voffB[2];
#pragma unroll
    for (int i = 0; i < 2; ++i) { int R, C; stage_rc(tid * 16 + i * 8192, R, C); const int Rb = Epi::PERM ? ((R & ~31) + perm32(R & 31)) : R;
        voffA[i] = (unsigned)(R * g.lda + C) * 2u; voffB[i] = (unsigned)(Rb * g.ldb + C) * 2u; }
    const size_t kstep = (size_t)(BK * 2);
    const size_t hstepA = (size_t)HALF * g.lda * 2, hstepB = (size_t)HALF * g.ldb * 2;
    const size_t tstepA = 2 * hstepA, tstepB = 2 * hstepB;
    const unsigned ldsw = (unsigned)wid * 1024u;
    const int aoff = lds_byte(wr * 64 + fr, fq * 8), boff = lds_byte(wc * 32 + fr, fq * 8);
#define PG8_SA(b, h) (((b) * 2 + (h)) * HTB)
#define PG8_SB(b, h) ((4 + (b) * 2 + (h)) * HTB)
#define PG8_STAGE(bufoff, gbase, voff) do { _Pragma("unroll") for (int _i = 0; _i < 2; ++_i) \
        __builtin_amdgcn_global_load_lds((const unsigned*)((const char*)(gbase) + (voff)[_i]), (LAS unsigned*)(lds + (bufoff) + ldsw + _i * 8192), 16, 0, 0); } while (0)
#define PG8_LDA(dst, b, h) do { _Pragma("unroll") for (int m = 0; m < 4; ++m) _Pragma("unroll") for (int k = 0; k < 2; ++k) dst[m][k] = *(const LAS bf16x8*)(lds + PG8_SA(b, h) + aoff + m * 2048 + k * 1024); } while (0)
#define PG8_LDB(dst, b, h) do { _Pragma("unroll") for (int n = 0; n < 2; ++n) _Pragma("unroll") for (int k = 0; k < 2; ++k) dst[n][k] = *(const LAS bf16x8*)(lds + PG8_SB(b, h) + boff + n * 2048 + k * 1024); } while (0)
#define PG8_MMA(ai, bj, At, Bt) do { __builtin_amdgcn_s_setprio(1); _Pragma("unroll") for (int m = 0; m < 4; ++m) _Pragma("unroll") for (int n = 0; n < 2; ++n) _Pragma("unroll") for (int k = 0; k < 2; ++k) \
        acc[ai][bj][m][n] = __builtin_amdgcn_mfma_f32_16x16x32_bf16(Bt[n][k], At[m][k], acc[ai][bj][m][n], 0, 0, 0); __builtin_amdgcn_s_setprio(0); } while (0)
#define PG8_WAIT_V(n) asm volatile("s_waitcnt vmcnt(" #n ")" ::: "memory")
#define PG8_WAIT_L(n) asm volatile("s_waitcnt lgkmcnt(" #n ")" ::: "memory")
#define PG8_BAR __builtin_amdgcn_s_barrier()
#define PG8_SCHED __builtin_amdgcn_sched_barrier(0)
    Unit cur, nxt; int ui = 0;
    if (!S.next(0, cur)) return;
    f32x4 acc[2][2][4][2];
#pragma unroll
    for (int a = 0; a < 2; ++a)
#pragma unroll
        for (int b = 0; b < 2; ++b)
#pragma unroll
            for (int m = 0; m < 4; ++m)
#pragma unroll
                for (int n = 0; n < 2; ++n) acc[a][b][m][n] = (f32x4){0.f, 0.f, 0.f, 0.f};
    bf16x8 At[4][2], B0[2][2], B1[2][2];
    const char* cA = (const char*)g.A + (size_t)cur.pm * tstepA + (size_t)cur.ka * 2; const char* cB = (const char*)g.Bt + (size_t)cur.pn * tstepB;
    PG8_STAGE(PG8_SB(0, 0), cB, voffB); PG8_STAGE(PG8_SA(0, 0), cA, voffA); PG8_STAGE(PG8_SB(0, 1), cB + hstepB, voffB); PG8_STAGE(PG8_SA(0, 1), cA + hstepA, voffA);
    if (wr == 1) PG8_BAR;
    PG8_WAIT_V(4); PG8_BAR;
    PG8_STAGE(PG8_SB(1, 0), cB + kstep, voffB); PG8_STAGE(PG8_SA(1, 0), cA + kstep, voffA); PG8_STAGE(PG8_SB(1, 1), cB + hstepB + kstep, voffB);
    PG8_WAIT_V(6); PG8_BAR;
    for (;;) {
        const bool has_next = S.next(ui + 1, nxt);
        const char* nA = has_next ? (const char*)g.A + (size_t)nxt.pm * tstepA + (size_t)nxt.ka * 2 : cA; const char* nB = has_next ? (const char*)g.Bt + (size_t)nxt.pn * tstepB : cB;
        for (int t = 0; t < nt; t += 2) {
            const bool last = (t == nt - 2);
            const char* a1 = cA + (size_t)(t + 1) * kstep;
            const char* a2 = last ? nA : cA + (size_t)(t + 2) * kstep; const char* b2 = last ? nB : cB + (size_t)(t + 2) * kstep;
            const char* a3 = a2 + kstep; const char* b3 = b2 + kstep;
            PG8_LDB(B0, 0, 0); PG8_SCHED; PG8_LDA(At, 0, 0); PG8_STAGE(PG8_SA(1, 1), a1 + hstepA, voffA);
            PG8_WAIT_L(8); PG8_BAR; PG8_WAIT_L(0); PG8_MMA(0, 0, At, B0); PG8_BAR; PG8_SCHED;
            PG8_LDB(B1, 0, 1); PG8_STAGE(PG8_SB(0, 0), b2, voffB);
            PG8_BAR; PG8_WAIT_L(0); PG8_MMA(0, 1, At, B1); PG8_BAR;
            PG8_LDA(At, 0, 1); PG8_STAGE(PG8_SA(0, 0), a2, voffA);
            PG8_BAR; PG8_WAIT_L(0); PG8_MMA(1, 0, At, B0); PG8_BAR; PG8_SCHED;
            PG8_STAGE(PG8_SB(0, 1), b2 + hstepB, voffB);
            PG8_WAIT_V(6); PG8_BAR; PG8_MMA(1, 1, At, B1); PG8_BAR;
            PG8_LDB(B0, 1, 0); PG8_SCHED; PG8_LDA(At, 1, 0); PG8_STAGE(PG8_SA(0, 1), a2 + hstepA, voffA);
            PG8_WAIT_L(8); PG8_BAR; PG8_WAIT_L(0); PG8_MMA(0, 0, At, B0); PG8_BAR; PG8_SCHED;
            PG8_LDB(B1, 1, 1); PG8_STAGE(PG8_SB(1, 0), b3, voffB);
            PG8_BAR; PG8_WAIT_L(0); PG8_MMA(0, 1, At, B1); PG8_BAR;
            PG8_LDA(At, 1, 1); PG8_STAGE(PG8_SA(1, 0), a3, voffA);
            PG8_BAR; PG8_WAIT_L(0); PG8_MMA(1, 0, At, B0); PG8_BAR; PG8_SCHED;
            PG8_STAGE(PG8_SB(1, 1), b3 + hstepB, voffB);
            PG8_WAIT_V(6); PG8_BAR; PG8_MMA(1, 1, At, B1); PG8_BAR;
        }
        E(acc, cur, wr, wc, fr, fq);
        if (!has_next) break;
#pragma unroll
        for (int a = 0; a < 2; ++a)
#pragma unroll
            for (int b = 0; b < 2; ++b)
#pragma unroll
                for (int m = 0; m < 4; ++m)
#pragma unroll
                    for (int n = 0; n < 2; ++n) acc[a][b][m][n] = (f32x4){0.f, 0.f, 0.f, 0.f};
        cur = nxt; cA = nA; cB = nB; ++ui;
    }
    PG8_WAIT_V(0);
    if (wr == 0) PG8_BAR;
    PG8_BAR;
#undef PG8_SA
#undef PG8_SB
#undef PG8_STAGE
#undef PG8_LDA
#undef PG8_LDB
#undef PG8_MMA
#undef PG8_WAIT_V
#undef PG8_WAIT_L
#undef PG8_BAR
#undef PG8_SCHED
}

struct SchedGrid {
    int nM, nN, G, c, kaMode;
    __device__ bool next(int i, Unit& u) const {
        const int L = i * G + c; if (L >= nM * nN) return false;
        std_tile(L, nM, nN, u.pm, u.pn);
        u.ka = kaMode == 0 ? 0 : (kaMode == 1 ? (u.pn & ~1) * 128 : u.pn * 256);
        return true;
    }
};
struct Sched1 {
    int G, c;
    __device__ bool next(int i, Unit& u) const {
        const int L = i * G + c; u.ka = 0;
        if (L < 32 * 48) { std_tile(L, 32, 48, u.pm, u.pn); return true; }
        const int j = L - 32 * 48; if (j >= 32) return false;
        u.pm = 33 + (j >> 3); u.pn = 48 + (j & 7); return true;
    }
};
struct SchedMKV {
    int G, c;
    __device__ bool next(int i, Unit& u) const { const int L = i * G + c; if (L >= 32) return false; u.pm = 33 + (L >> 3); u.pn = 48 + (L & 7); u.ka = 0; return true; }
};
struct Sched5 {
    int G, c;
    __device__ bool next(int i, Unit& u) const {
        const int T = (i / 3) * G + c, j = i % 3; if (T >= 32 * 8) return false;
        int pm, pn; std_tile(T, 32, 8, pm, pn);
        u.pm = j * 33 + pm; u.pn = j * 8 + pn; u.ka = 0; return true;
    }
};

struct Epi1 {
    static constexpr bool PERM = true;
    bf16_t* Z; float* omk; float* omv; bf16_t* MKB; bf16_t* VTB;
    __device__ __forceinline__ void operator()(const f32x4 (&acc)[2][2][4][2], const Unit& u, int wr, int wc, int fr, int fq) const {
        if (u.pn < 48) {
            const int row0 = u.pm * BM + wr * 64 + fr, col0 = u.pn * BM + wc * 32 + 8 * fq;
#pragma unroll
            for (int ai = 0; ai < 2; ++ai)
#pragma unroll
                for (int m = 0; m < 4; ++m) { bf16_t* rowp = Z + (size_t)(row0 + ai * HALF + m * 16) * INW + col0;
#pragma unroll
                    for (int bj = 0; bj < 2; ++bj) { const f32x4 v0 = acc[ai][bj][m][0], v1 = acc[ai][bj][m][1];
                        u32x4 w; w.x = cvt_pk_bf16(v0[0], v0[1]); w.y = cvt_pk_bf16(v0[2], v0[3]); w.z = cvt_pk_bf16(v1[0], v1[1]); w.w = cvt_pk_bf16(v1[2], v1[3]);
                        *(u32x4*)(rowp + bj * HALF) = w; } }
        } else {
            const int row0 = (u.pm - 33) * BM + wr * 64 + fr, col0 = (u.pn - 48) * BM + wc * 32 + 8 * fq;
            const bool isv = (u.pn - 48) >= 4;
#pragma unroll
            for (int ai = 0; ai < 2; ++ai)
#pragma unroll
                for (int m = 0; m < 4; ++m) { const int row = row0 + ai * HALF + m * 16;
#pragma unroll
                    for (int bj = 0; bj < 2; ++bj) { const f32x4 v0 = acc[ai][bj][m][0], v1 = acc[ai][bj][m][1]; const int col = col0 + bj * HALF;
                        if (!isv) {
                            float* o = omk + (size_t)row * 1024 + col; *(f32x4*)o = v0; *(f32x4*)(o + 4) = v1;
                            u32x4 w; w.x = cvt_pk_bf16(v0[0], v0[1]); w.y = cvt_pk_bf16(v0[2], v0[3]); w.z = cvt_pk_bf16(v1[0], v1[1]); w.w = cvt_pk_bf16(v1[2], v1[3]);
                            *(u32x4*)(MKB + (size_t)row * 1024 + col) = w;
                        } else {
                            const int cm = col - 1024; float* o = omv + (size_t)row * 1024 + cm; *(f32x4*)o = v0; *(f32x4*)(o + 4) = v1;
                            bf16_t* vt = VTB + ((size_t)(row >> 8) * 1024 + cm) * 256 + (row & 255);
#pragma unroll
                            for (int e = 0; e < 4; ++e) { vt[(size_t)e * 256] = f2bf(v0[e]); vt[(size_t)(e + 4) * 256] = f2bf(v1[e]); }
                        } } }
        }
    }
};
struct Epi3 {
    static constexpr bool PERM = false;
    const bf16_t* __restrict__ XR; float* __restrict__ SA; float* __restrict__ SU; const float* ba; const float* bx; const float* lam;
    __device__ __forceinline__ void operator()(const f32x4 (&acc)[2][2][4][2], const Unit& u, int wr, int wc, int fr, int fq) const {
        const int row0 = u.pm * BM + wr * 64 + fr, ch0 = u.pn * 128 + wc * 32 + 4 * fq;
        u32x2 xw[2][2][4];
#pragma unroll
        for (int n = 0; n < 2; ++n)
#pragma unroll
            for (int ai = 0; ai < 2; ++ai)
#pragma unroll
                for (int m = 0; m < 4; ++m) xw[n][ai][m] = *(const u32x2*)(XR + (size_t)(row0 + ai * HALF + m * 16) * 1024 + ch0 + n * 16);
#pragma unroll
        for (int n = 0; n < 2; ++n) {
            const int ch = ch0 + n * 16;
            const f32x4 vba = *(const f32x4*)(ba + ch), vbx = *(const f32x4*)(bx + ch), l = *(const f32x4*)(lam + ch); f32x4 vsp;
#pragma unroll
            for (int j = 0; j < 4; ++j) { const float ex = fast_exp(-l[j]);
                const float sp = ex < 0.03f ? ex * (1.0f + ex * (-0.5f + ex * (0.33333333f - 0.25f * ex))) : __logf(1.0f + ex); vsp[j] = -8.0f * sp; }
#pragma unroll
            for (int ai = 0; ai < 2; ++ai)
#pragma unroll
                for (int m = 0; m < 4; ++m) { const int row = row0 + ai * HALF + m * 16; if (row >= TT) continue;
                    const u32x2 xv = xw[n][ai][m];
                    const float xr[4] = {bf_lo(xv.x), bf_hi(xv.x), bf_lo(xv.y), bf_hi(xv.y)}; f32x4 av, uv;
#pragma unroll
                    for (int j = 0; j < 4; ++j) { const float r = sigmoidf_(acc[ai][0][m][n][j] + vba[j]), ig = sigmoidf_(acc[ai][1][m][n][j] + vbx[j]);
                        const float la = vsp[j] * r; av[j] = fast_exp(la); uv[j] = __builtin_amdgcn_sqrtf(fmaxf(1.0f - fast_exp(2.0f * la), 0.f)) * ig * xr[j]; }
                    *(f32x4*)(SA + (size_t)row * 1024 + ch) = av; *(f32x4*)(SU + (size_t)row * 1024 + ch) = uv; }
        }
    }
};
struct Epi5 {
    static constexpr bool PERM = true;
    const bf16_t* __restrict__ Z; bf16_t* __restrict__ P0; bf16_t* __restrict__ P1; bf16_t* __restrict__ MB;
    __device__ __forceinline__ void operator()(const f32x4 (&acc)[2][2][4][2], const Unit& u, int wr, int wc, int fr, int fq) const {
        const int j = u.pn >> 3, pm = u.pm - j * 33, pn = u.pn & 7;
        const int row0 = pm * BM + wr * 64 + fr, col0 = pn * BM + wc * 32 + 8 * fq;
        const bf16_t* __restrict__ src = (j == 1) ? P0 : P1; bf16_t* __restrict__ dst = (j == 0) ? P0 : (j == 1 ? P1 : MB);
#pragma unroll
        for (int ai = 0; ai < 2; ++ai) {
            u32x4 gw[4][2], pw[4][2];
#pragma unroll
            for (int m = 0; m < 4; ++m)
#pragma unroll
                for (int bj = 0; bj < 2; ++bj) { const int row = row0 + ai * HALF + m * 16, col = col0 + bj * HALF;
                    gw[m][bj] = *(const u32x4*)(Z + (size_t)row * INW + 6144 + j * 2048 + col);
                    pw[m][bj] = (j > 0) ? *(const u32x4*)(src + (size_t)row * DM + col) : (u32x4){0u, 0u, 0u, 0u}; }
#pragma unroll
            for (int m = 0; m < 4; ++m)
#pragma unroll
                for (int bj = 0; bj < 2; ++bj) { const int row = row0 + ai * HALF + m * 16, col = col0 + bj * HALF;
                    float gv[8], pv[8], r[8]; unpack8(gw[m][bj], gv); unpack8(pw[m][bj], pv);
#pragma unroll
                    for (int e = 0; e < 4; ++e) { r[e] = sigmoidf_(gv[e]) * acc[ai][bj][m][0][e] + pv[e]; r[e + 4] = sigmoidf_(gv[e + 4]) * acc[ai][bj][m][1][e] + pv[e + 4]; }
                    *(u32x4*)(dst + (size_t)row * DM + col) = pack8(r); }
        }
    }
};
struct Epi6 {
    static constexpr bool PERM = false;
    const float* xp; const float* xs; float* H1;
    __device__ __forceinline__ void operator()(const f32x4 (&acc)[2][2][4][2], const Unit& u, int wr, int wc, int fr, int fq) const {
        const int row0 = u.pm * BM + wr * 64 + fr, col0 = u.pn * BM + wc * 32 + 4 * fq;
#pragma unroll
        for (int ai = 0; ai < 2; ++ai)
#pragma unroll
            for (int m = 0; m < 4; ++m) { const int row = row0 + ai * HALF + m * 16; if (row >= TT) continue;
                const float* xrow = row < TP ? xp + (size_t)row * DM : xs + (size_t)(row - TP) * DM;
#pragma unroll
                for (int bj = 0; bj < 2; ++bj)
#pragma unroll
                    for (int n = 0; n < 2; ++n) { const int col = col0 + bj * HALF + n * 16; const f32x4 xv = *(const f32x4*)(xrow + col);
                        *(f32x4*)(H1 + (size_t)row * DM + col) = xv * DN_ALPHA + acc[ai][bj][m][n]; } }
    }
};
struct EpiB {
    static constexpr bool PERM = true;
    bf16_t* O; int ldc;
    __device__ __forceinline__ void operator()(const f32x4 (&acc)[2][2][4][2], const Unit& u, int wr, int wc, int fr, int fq) const {
        const int row0 = u.pm * BM + wr * 64 + fr, col0 = u.pn * BM + wc * 32 + 8 * fq;
#pragma unroll
        for (int ai = 0; ai < 2; ++ai)
#pragma unroll
            for (int m = 0; m < 4; ++m) { bf16_t* rowp = O + (size_t)(row0 + ai * HALF + m * 16) * ldc + col0;
#pragma unroll
                for (int bj = 0; bj < 2; ++bj) { const f32x4 v0 = acc[ai][bj][m][0], v1 = acc[ai][bj][m][1];
                    u32x4 w; w.x = cvt_pk_bf16(v0[0], v0[1]); w.y = cvt_pk_bf16(v0[2], v0[3]); w.z = cvt_pk_bf16(v1[0], v1[1]); w.w = cvt_pk_bf16(v1[2], v1[3]);
                    *(u32x4*)(rowp + bj * HALF) = w; } }
    }
};
struct EpiF {
    static constexpr bool PERM = false;
    float* C; int ldc;
    __device__ __forceinline__ void operator()(const f32x4 (&acc)[2][2][4][2], const Unit& u, int wr, int wc, int fr, int fq) const {
        const int row0 = u.pm * BM + wr * 64 + fr, col0 = u.pn * BM + wc * 32 + 4 * fq;
#pragma unroll
        for (int ai = 0; ai < 2; ++ai)
#pragma unroll
            for (int m = 0; m < 4; ++m) { float* rowp = C + (size_t)(row0 + ai * HALF + m * 16) * ldc + col0;
#pragma unroll
                for (int bj = 0; bj < 2; ++bj)
#pragma unroll
                    for (int n = 0; n < 2; ++n) *(f32x4*)(rowp + bj * HALF + n * 16) = acc[ai][bj][m][n]; }
    }
};

__device__ void cvt_flat(const float* __restrict__ src, bf16_t* __restrict__ dst, size_t n, size_t gtid, size_t gth) {
    for (size_t i = gtid * 8; i < n; i += gth * 8) {
        const f32x4 a = *(const f32x4*)(src + i), b = *(const f32x4*)(src + i + 4);
        u32x4 w; w.x = cvt_pk_bf16(a[0], a[1]); w.y = cvt_pk_bf16(a[2], a[3]); w.z = cvt_pk_bf16(b[0], b[1]); w.w = cvt_pk_bf16(b[2], b[3]);
        *(u32x4*)(dst + i) = w;
    }
}
__device__ void transpose_cvt(float* lds, const float* __restrict__ src, bf16_t* __restrict__ dst, int K, int N, int bid, int nb) {
    const int tn = N / 64, ntile = (K / 64) * tn;
    for (int t = bid; t < ntile; t += nb) {
        const int k0 = (t / tn) * 64, n0 = (t % tn) * 64;
#pragma unroll
        for (int i = 0; i < 2; ++i) { const int idx = threadIdx.x + i * 512, r = idx >> 4, c4 = (idx & 15) * 4;
            const f32x4 v = *(const f32x4*)(src + (size_t)(k0 + r) * N + n0 + c4);
            lds[r * 65 + c4] = v[0]; lds[r * 65 + c4 + 1] = v[1]; lds[r * 65 + c4 + 2] = v[2]; lds[r * 65 + c4 + 3] = v[3]; }
        __syncthreads();
        { const int n = threadIdx.x >> 3, kc = (threadIdx.x & 7) * 8; float v[8];
#pragma unroll
            for (int i = 0; i < 8; ++i) v[i] = lds[(kc + i) * 65 + n];
            *(u32x4*)(dst + (size_t)(n0 + n) * K + k0 + kc) = pack8(v); }
        __syncthreads();
    }
}


__device__ void cvt_fp8_rows(const float* __restrict__ src, unsigned char* __restrict__ dst, float* __restrict__ inv, int nrows, int gw, int nw) {
    const int lane = threadIdx.x & 63;
    for (int row = gw; row < nrows; row += nw) {
        f32x4 v[2][4]; float mx = 0.f;
#pragma unroll
        for (int j = 0; j < 2; ++j)
#pragma unroll
            for (int q = 0; q < 4; ++q) { v[j][q] = *(const f32x4*)(src + (size_t)row * 2048 + j * 1024 + lane * 16 + q * 4);
                mx = fmaxf(mx, fmaxf(fmaxf(fabsf(v[j][q][0]), fabsf(v[j][q][1])), fmaxf(fabsf(v[j][q][2]), fabsf(v[j][q][3])))); }
#pragma unroll
        for (int o = 32; o > 0; o >>= 1) mx = fmaxf(mx, __shfl_xor(mx, o, 64));
        int k = 8 - ((int)((__float_as_uint(mx) >> 23) & 0xffu) - 126); k = k > 100 ? 100 : (k < -100 ? -100 : k);
        if (mx == 0.f) k = 0;
        const float sc = __uint_as_float((unsigned)(127 + k) << 23), isc = __uint_as_float((unsigned)(127 - k) << 23);
#pragma unroll
        for (int j = 0; j < 2; ++j) { u32x4 w;
#pragma unroll
            for (int q = 0; q < 4; ++q) { int t = 0; t = __builtin_amdgcn_cvt_pk_fp8_f32(v[j][q][0] * sc, v[j][q][1] * sc, t, false); t = __builtin_amdgcn_cvt_pk_fp8_f32(v[j][q][2] * sc, v[j][q][3] * sc, t, true); w[q] = (unsigned)t; }
            *(u32x4*)(dst + (size_t)row * 2048 + j * 1024 + lane * 16) = w; }
        if (lane == 0) inv[row] = isc;
    }
}

__device__ void phase0(const Params& p, float* lds) {
    const int bid = blockIdx.x, nb = gridDim.x; const size_t gtid = (size_t)bid * 512 + threadIdx.x, gth = (size_t)nb * 512;
    unsigned char* ws = p.ws;
    bf16_t* AALL = (bf16_t*)(ws + W_AALL); bf16_t* BTALL = (bf16_t*)(ws + W_BTALL);
    transpose_cvt(lds, p.in[8], BTALL, 2048, 12288, bid, nb);
    transpose_cvt(lds, p.in[17], BTALL + (size_t)12288 * 2048, 2048, 1024, bid, nb);
    transpose_cvt(lds, p.in[18], BTALL + (size_t)13312 * 2048, 2048, 1024, bid, nb);
    transpose_cvt(lds, p.in[19], (bf16_t*)(ws + W_WBRT), 1024, 2048, bid, nb);
    transpose_cvt(lds, p.in[20], (bf16_t*)(ws + W_WBRT) + (size_t)2048 * 1024, 1024, 2048, bid, nb);
    transpose_cvt(lds, p.in[21], (bf16_t*)(ws + W_WBRT) + (size_t)2 * 2048 * 1024, 1024, 2048, bid, nb);
    transpose_cvt(lds, p.in[22], (bf16_t*)(ws + W_WOT), 2048, 2048, bid, nb);
    transpose_cvt(lds, p.in[25], (bf16_t*)(ws + W_WQT), 2048, 2048, bid, nb);
    cvt_flat(p.in[0], AALL, (size_t)TP * DM, gtid, gth);
    cvt_flat(p.in[1], AALL + (size_t)TP * DM, (size_t)TS * DM, gtid, gth);
    cvt_flat(p.in[2], AALL + (size_t)TPAD * DM, (size_t)NMEM * DM, gtid, gth);
    bf16_t* WGT = (bf16_t*)(ws + W_WGT); bf16_t* WKT = (bf16_t*)(ws + W_WKT);
    for (size_t idx = gtid; idx < (size_t)2048 * 256; idx += gth) {
        const int k = (int)(idx & 255), ng = (int)(idx >> 8), h = ng >> 8, n = ng & 255;
        float v = 0.f;
        if ((k >> 7) == (h & 1)) { const float* w = (n < 128) ? p.in[12] : p.in[14]; v = w[((size_t)h * 128 + (k & 127)) * 128 + (n & 127)]; }
        WGT[idx] = f2bf(v);
        float v2 = 0.f; const int c = n >> 7;
        if ((k >> 7) == c) v2 = p.in[26][(((size_t)h * 2 + c) * 128 + (n & 127)) * 128 + (k & 127)];
        WKT[idx] = f2bf(v2);
    }
}

__device__ __forceinline__ u32x4 ldz(const bf16_t* Z, int t, int col) { return *(const u32x4*)(Z + (size_t)t * INW + col); }

__device__ void p2_elem_prompt(const Params& p, int item) {
    const int TIDX = launder_tid();
    const bf16_t* __restrict__ Z = (const bf16_t*)(p.ws + W_Z); bf16_t* __restrict__ Y0 = (bf16_t*)(p.ws + W_YCAT); bf16_t* __restrict__ XR = (bf16_t*)(p.ws + W_XR);
    const int run = item * 4 + (TIDX >> 7), c0 = (TIDX & 127) * 8, t0 = run * 16, b = t0 >> 11, s0 = t0 & 2047;
    float cw[3][8], rw[4][8], rb[8];
#pragma unroll
    for (int k = 0; k < 3; ++k) { const f32x4 a = *(const f32x4*)(p.in[9] + k * 1024 + c0), bb = *(const f32x4*)(p.in[9] + k * 1024 + c0 + 4);
#pragma unroll
        for (int e = 0; e < 4; ++e) { cw[k][e] = a[e]; cw[k][e + 4] = bb[e]; } }
#pragma unroll
    for (int k = 0; k < 4; ++k) { const f32x4 a = *(const f32x4*)(p.in[10] + k * 1024 + c0), bb = *(const f32x4*)(p.in[10] + k * 1024 + c0 + 4);
#pragma unroll
        for (int e = 0; e < 4; ++e) { rw[k][e] = a[e]; rw[k][e + 4] = bb[e]; } }
    { const f32x4 a = *(const f32x4*)(p.in[11] + c0), bb = *(const f32x4*)(p.in[11] + c0 + 4);
#pragma unroll
        for (int e = 0; e < 4; ++e) { rb[e] = a[e]; rb[e + 4] = bb[e]; } }
    float z2[8], z1[8], r3[8], r2[8], r1[8];
#pragma unroll
    for (int e = 0; e < 8; ++e) { z2[e] = z1[e] = r3[e] = r2[e] = r1[e] = 0.f; }
    if (s0 > 0) {
        float a[8], bb[8];
        unpack8(ldz(Z, t0 - 2, 1024 + c0), a); unpack8(ldz(Z, t0 - 2, 2048 + c0), bb);
#pragma unroll
        for (int e = 0; e < 8; ++e) z2[e] = a[e] * bb[e];
        unpack8(ldz(Z, t0 - 1, 1024 + c0), a); unpack8(ldz(Z, t0 - 1, 2048 + c0), bb);
#pragma unroll
        for (int e = 0; e < 8; ++e) z1[e] = a[e] * bb[e];
        unpack8(ldz(Z, t0 - 3, 3072 + c0), r3); unpack8(ldz(Z, t0 - 2, 3072 + c0), r2); unpack8(ldz(Z, t0 - 1, 3072 + c0), r1);
    }
#pragma unroll 1
    for (int sb = 0; sb < 16; sb += 4) {
        u32x4 wcb[4], wcc[4], wcx[4], wrx[4];
#pragma unroll
        for (int s = 0; s < 4; ++s) { const int t = t0 + sb + s; wcb[s] = ldz(Z, t, c0); wcc[s] = ldz(Z, t, 1024 + c0); wcx[s] = ldz(Z, t, 2048 + c0); wrx[s] = ldz(Z, t, 3072 + c0); }
#pragma unroll
        for (int s = 0; s < 4; ++s) {
            const int t = t0 + sb + s, sq = s0 + sb + s;
            float cb[8], cc[8], cx[8], rx[8], zc[8], yc[8], xr[8];
            unpack8(wcb[s], cb); unpack8(wcc[s], cc); unpack8(wcx[s], cx); unpack8(wrx[s], rx);
#pragma unroll
            for (int e = 0; e < 8; ++e) { zc[e] = cc[e] * cx[e]; yc[e] = cb[e] * (cw[0][e] * z2[e] + cw[1][e] * z1[e] + cw[2][e] * zc[e]);
                xr[e] = rw[0][e] * r3[e] + rw[1][e] * r2[e] + rw[2][e] * r1[e] + rw[3][e] * rx[e] + rb[e]; }
            *(u32x4*)(Y0 + (size_t)t * 1024 + c0) = pack8(yc);
            *(u32x4*)(XR + (size_t)t * 1024 + c0) = pack8(xr);
            if (sq >= 2046) { float* o = p.out + O_CZP + ((size_t)b * 2 + (sq - 2046)) * 1024 + c0; *(f32x4*)o = (f32x4){zc[0], zc[1], zc[2], zc[3]}; *(f32x4*)(o + 4) = (f32x4){zc[4], zc[5], zc[6], zc[7]}; }
            if (sq >= 2045) { float* o = p.out + O_RCP + ((size_t)b * 3 + (sq - 2045)) * 1024 + c0; *(f32x4*)o = (f32x4){rx[0], rx[1], rx[2], rx[3]}; *(f32x4*)(o + 4) = (f32x4){rx[4], rx[5], rx[6], rx[7]}; }
#pragma unroll
            for (int e = 0; e < 8; ++e) { z2[e] = z1[e]; z1[e] = zc[e]; r3[e] = r2[e]; r2[e] = r1[e]; r1[e] = rx[e]; }
        }
    }
}
__device__ __forceinline__ void ld8f(const float* p, float* v) { const f32x4 a = *(const f32x4*)p, b = *(const f32x4*)(p + 4);
#pragma unroll
    for (int e = 0; e < 4; ++e) { v[e] = a[e]; v[e + 4] = b[e]; } }
__device__ __forceinline__ void st8f(float* p, const float* v) { *(f32x4*)p = (f32x4){v[0], v[1], v[2], v[3]}; *(f32x4*)(p + 4) = (f32x4){v[4], v[5], v[6], v[7]}; }

__device__ void p2_elem_sample(const Params& p, int item) {
    const int TIDX = launder_tid();
    const bf16_t* Z = (const bf16_t*)(p.ws + W_Z); bf16_t* Y0 = (bf16_t*)(p.ws + W_YCAT); bf16_t* XR = (bf16_t*)(p.ws + W_XR);
    const int bs = item * 4 + (TIDX >> 7), c0 = (TIDX & 127) * 8, t = TP + bs;
    float cw[3][8], rw[4][8], rb[8], z2[8], z1[8], r3[8], r2[8], r1[8];
#pragma unroll
    for (int k = 0; k < 3; ++k) ld8f(p.in[9] + k * 1024 + c0, cw[k]);
#pragma unroll
    for (int k = 0; k < 4; ++k) ld8f(p.in[10] + k * 1024 + c0, rw[k]);
    ld8f(p.in[11] + c0, rb);
    ld8f(p.in[5] + ((size_t)bs * 2 + 0) * 1024 + c0, z2); ld8f(p.in[5] + ((size_t)bs * 2 + 1) * 1024 + c0, z1);
    ld8f(p.in[6] + ((size_t)bs * 3 + 0) * 1024 + c0, r3); ld8f(p.in[6] + ((size_t)bs * 3 + 1) * 1024 + c0, r2); ld8f(p.in[6] + ((size_t)bs * 3 + 2) * 1024 + c0, r1);
    float cb[8], cc[8], cx[8], rx[8], zc[8], yc[8], xr[8];
    unpack8(ldz(Z, t, c0), cb); unpack8(ldz(Z, t, 1024 + c0), cc); unpack8(ldz(Z, t, 2048 + c0), cx); unpack8(ldz(Z, t, 3072 + c0), rx);
#pragma unroll
    for (int e = 0; e < 8; ++e) { zc[e] = cc[e] * cx[e]; yc[e] = cb[e] * (cw[0][e] * z2[e] + cw[1][e] * z1[e] + cw[2][e] * zc[e]);
        xr[e] = rw[0][e] * r3[e] + rw[1][e] * r2[e] + rw[2][e] * r1[e] + rw[3][e] * rx[e] + rb[e]; }
    *(u32x4*)(Y0 + (size_t)t * 1024 + c0) = pack8(yc);
    *(u32x4*)(XR + (size_t)t * 1024 + c0) = pack8(xr);
    st8f(p.out + O_CZS + ((size_t)bs * 2 + 0) * 1024 + c0, z1); st8f(p.out + O_CZS + ((size_t)bs * 2 + 1) * 1024 + c0, zc);
    st8f(p.out + O_RCS + ((size_t)bs * 3 + 0) * 1024 + c0, r2); st8f(p.out + O_RCS + ((size_t)bs * 3 + 1) * 1024 + c0, r1); st8f(p.out + O_RCS + ((size_t)bs * 3 + 2) * 1024 + c0, rx);
}

__device__ void p2_attn_prompt(const Params& p, int item) {
    const bf16_t* Z = (const bf16_t*)(p.ws + W_Z); const bf16_t* MKB = (const bf16_t*)(p.ws + W_MKB); const bf16_t* VTB = (const bf16_t*)(p.ws + W_VTB);
    bf16_t* Y2 = (bf16_t*)(p.ws + W_YCAT) + (size_t)2 * TPAD * 1024;
    const int b = item >> 6, h = (item >> 4) & 3, qt = item & 15;
    const int w = threadIdx.x >> 6, lane = threadIdx.x & 63, fr = lane & 15, fq = lane >> 4;
    const int t = b * 2048 + qt * 128 + w * 16 + fr;
    bf16x8 qf[8];
#pragma unroll
    for (int ks = 0; ks < 8; ++ks) qf[ks] = *(const bf16x8*)(Z + (size_t)t * INW + 5120 + h * 256 + ks * 32 + fq * 8);
    f32x4 sacc[16];
#pragma unroll
    for (int nb = 0; nb < 16; ++nb) {
        sacc[nb] = (f32x4){0.f, 0.f, 0.f, 0.f};
        const bf16_t* kp = MKB + (size_t)(b * 256 + nb * 16 + fr) * 1024 + h * 256 + fq * 8;
#pragma unroll
        for (int ks = 0; ks < 8; ++ks) { const bf16x8 kf = *(const bf16x8*)(kp + ks * 32); sacc[nb] = __builtin_amdgcn_mfma_f32_16x16x32_bf16(kf, qf[ks], sacc[nb], 0, 0, 0); }
    }
    float mx = -3.0e38f;
#pragma unroll
    for (int nb = 0; nb < 16; ++nb)
#pragma unroll
        for (int j = 0; j < 4; ++j) { sacc[nb][j] *= 0.0625f; mx = fmaxf(mx, sacc[nb][j]); }
    mx = fmaxf(mx, __shfl_xor(mx, 16, 64)); mx = fmaxf(mx, __shfl_xor(mx, 32, 64));
    float sum = 0.f;
#pragma unroll
    for (int nb = 0; nb < 16; ++nb)
#pragma unroll
        for (int j = 0; j < 4; ++j) { sacc[nb][j] = fast_exp(sacc[nb][j] - mx); sum += sacc[nb][j]; }
    sum += __shfl_xor(sum, 16, 64); sum += __shfl_xor(sum, 32, 64);
    const float inv = 1.0f / sum;
    bf16x8 pf[8];
#pragma unroll
    for (int s2 = 0; s2 < 8; ++s2) {
        u32x4 w4; w4.x = cvt_pk_bf16(sacc[2 * s2][0] * inv, sacc[2 * s2][1] * inv); w4.y = cvt_pk_bf16(sacc[2 * s2][2] * inv, sacc[2 * s2][3] * inv);
        w4.z = cvt_pk_bf16(sacc[2 * s2 + 1][0] * inv, sacc[2 * s2 + 1][1] * inv); w4.w = cvt_pk_bf16(sacc[2 * s2 + 1][2] * inv, sacc[2 * s2 + 1][3] * inv);
        pf[s2] = __builtin_bit_cast(bf16x8, w4);
    }
#pragma unroll 4
    for (int db = 0; db < 16; ++db) {
        f32x4 o = (f32x4){0.f, 0.f, 0.f, 0.f};
        const bf16_t* vp = VTB + ((size_t)b * 1024 + h * 256 + db * 16 + fr) * 256 + fq * 4;
#pragma unroll
        for (int s2 = 0; s2 < 8; ++s2) { const u32x2 v0 = *(const u32x2*)(vp + s2 * 32), v1 = *(const u32x2*)(vp + s2 * 32 + 16);
            u32x4 vv; vv.x = v0.x; vv.y = v0.y; vv.z = v1.x; vv.w = v1.y;
            o = __builtin_amdgcn_mfma_f32_16x16x32_bf16(__builtin_bit_cast(bf16x8, vv), pf[s2], o, 0, 0, 0); }
        u32x2 ow; ow.x = cvt_pk_bf16(o[0], o[1]); ow.y = cvt_pk_bf16(o[2], o[3]);
        *(u32x2*)(Y2 + (size_t)t * 1024 + h * 256 + db * 16 + fq * 4) = ow;
    }
}

__device__ void p2_attn_sample(const Params& p, int pair, float* lds) {
    const int TIDX = launder_tid();
    const bf16_t* Z = (const bf16_t*)(p.ws + W_Z); bf16_t* Y2 = (bf16_t*)(p.ws + W_YCAT) + (size_t)2 * TPAD * 1024;
    const int w = TIDX >> 6, lane = TIDX & 63, kq = lane >> 4, dl = lane & 15;
    const int b = pair >> 2, h = pair & 3;
    f32x4 qv[4];
#pragma unroll
    for (int j = 0; j < 4; ++j) { const u32x2 qw = *(const u32x2*)(Z + (size_t)(TP + b) * INW + 5120 + h * 256 + dl * 4 + 64 * j);
        qv[j] = (f32x4){bf_lo(qw.x), bf_hi(qw.x), bf_lo(qw.y), bf_hi(qw.y)} * 0.0625f; }
    const float* Kc = p.in[3]; const float* Vc = p.in[4];
    float sc[8];
#pragma unroll
    for (int i = 0; i < 8; ++i) {
        const int key = w * 32 + 4 * i + kq; const float* kp = Kc + (((size_t)b * 256 + key) * 4 + h) * 256 + dl * 4;
        float d = 0.f;
#pragma unroll
        for (int j = 0; j < 4; ++j) { const f32x4 kv = *(const f32x4*)(kp + 64 * j); d += kv[0] * qv[j][0] + kv[1] * qv[j][1] + kv[2] * qv[j][2] + kv[3] * qv[j][3]; }
        d += __shfl_xor(d, 1, 64); d += __shfl_xor(d, 2, 64); d += __shfl_xor(d, 4, 64); d += __shfl_xor(d, 8, 64);
        sc[i] = d;
    }
    float mx = sc[0];
#pragma unroll
    for (int i = 1; i < 8; ++i) mx = fmaxf(mx, sc[i]);
    mx = fmaxf(mx, __shfl_xor(mx, 16, 64)); mx = fmaxf(mx, __shfl_xor(mx, 32, 64));
    float l = 0.f; f32x4 o[4];
#pragma unroll
    for (int j = 0; j < 4; ++j) o[j] = (f32x4){0.f, 0.f, 0.f, 0.f};
#pragma unroll
    for (int i = 0; i < 8; ++i) {
        const float pe = fast_exp(sc[i] - mx); l += pe;
        const int key = w * 32 + 4 * i + kq; const float* vp = Vc + (((size_t)b * 256 + key) * 4 + h) * 256 + dl * 4;
#pragma unroll
        for (int j = 0; j < 4; ++j) { const f32x4 vv = *(const f32x4*)(vp + 64 * j); o[j] += vv * pe; }
    }
    l += __shfl_xor(l, 16, 64); l += __shfl_xor(l, 32, 64);
#pragma unroll
    for (int j = 0; j < 4; ++j)
#pragma unroll
        for (int e = 0; e < 4; ++e) { float v = o[j][e]; v += __shfl_xor(v, 16, 64); v += __shfl_xor(v, 32, 64); o[j][e] = v; }
    float* my = lds + w * 260;
    if (kq == 0) {
#pragma unroll
        for (int j = 0; j < 4; ++j) *(f32x4*)(my + dl * 4 + 64 * j) = o[j];
        if (dl == 0) { my[256] = mx; my[257] = l; }
    }
    __syncthreads();
    if (TIDX < 256) {
        const int d = TIDX; float M = lds[256];
#pragma unroll
        for (int ww = 1; ww < 8; ++ww) M = fmaxf(M, lds[ww * 260 + 256]);
        float L = 0.f, v = 0.f;
#pragma unroll
        for (int ww = 0; ww < 8; ++ww) { const float e = fast_exp(lds[ww * 260 + 256] - M); L += e * lds[ww * 260 + 257]; v += e * lds[ww * 260 + d]; }
        Y2[(size_t)(TP + b) * 1024 + h * 256 + d] = f2bf(v / L);
    }
    __syncthreads();
}

template <int NB>
__device__ __forceinline__ void skinny_acc(f32x4 (&acc)[NB], const bf16_t* __restrict__ Arow, const bf16_t* __restrict__ Brow, size_t nbstride, int K) {
    bf16x8 a0[4], b0[NB][4], a1[4], b1[NB][4];
#define SK_LOAD(a, b, kk) do { _Pragma("unroll") for (int s2 = 0; s2 < 4; ++s2) { a[s2] = *(const bf16x8*)(Arow + (kk) + s2 * 32); \
        _Pragma("unroll") for (int nb = 0; nb < NB; ++nb) b[nb][s2] = *(const bf16x8*)(Brow + nb * nbstride + (kk) + s2 * 32); } } while (0)
#define SK_MMA(a, b) do { _Pragma("unroll") for (int s2 = 0; s2 < 4; ++s2) _Pragma("unroll") for (int nb = 0; nb < NB; ++nb) acc[nb] = __builtin_amdgcn_mfma_f32_16x16x32_bf16(b[nb][s2], a[s2], acc[nb], 0, 0, 0); } while (0)
    SK_LOAD(a0, b0, 0);
#pragma unroll 1
    for (int k0 = 0; k0 < K; k0 += 256) {
        SK_LOAD(a1, b1, k0 + 128);
        SK_MMA(a0, b0);
        if (k0 + 256 < K) SK_LOAD(a0, b0, k0 + 256);
        SK_MMA(a1, b1);
    }
#undef SK_LOAD
#undef SK_MMA
}

template <int NB, int KB>
__device__ __forceinline__ void skinny_k(f32x4 (&acc)[NB][8], const bf16_t* __restrict__ A0, int lda, const bf16_t* __restrict__ B0, size_t nbstride, int ksteps) {
#pragma unroll 1
    for (int ks = 0; ks < ksteps; ks += KB) {
        bf16x8 a[KB][8], b[KB][NB];
#pragma unroll
        for (int s2 = 0; s2 < KB; ++s2) {
#pragma unroll
            for (int rb = 0; rb < 8; ++rb) a[s2][rb] = *(const bf16x8*)(A0 + (size_t)rb * 16 * lda + (ks + s2) * 32);
#pragma unroll
            for (int nb = 0; nb < NB; ++nb) b[s2][nb] = *(const bf16x8*)(B0 + nb * nbstride + (ks + s2) * 32); }
#pragma unroll
        for (int s2 = 0; s2 < KB; ++s2)
#pragma unroll
            for (int nb = 0; nb < NB; ++nb)
#pragma unroll
                for (int rb = 0; rb < 8; ++rb) acc[nb][rb] = __builtin_amdgcn_mfma_f32_16x16x32_bf16(b[s2][nb], a[s2][rb], acc[nb][rb], 0, 0, 0);
    }
}
__device__ __forceinline__ f32x4 xwave_reduce(float* lds, const f32x4 (&acc)[8], int w, int lane) {
    __syncthreads();
#pragma unroll
    for (int rb = 0; rb < 8; ++rb) *(f32x4*)(lds + ((w * 8 + rb) * 64 + lane) * 4) = acc[rb];
    __syncthreads();
    f32x4 v = *(const f32x4*)(lds + ((0 * 8 + w) * 64 + lane) * 4);
#pragma unroll
    for (int w2 = 1; w2 < 8; ++w2) v += *(const f32x4*)(lds + ((w2 * 8 + w) * 64 + lane) * 4);
    return v;
}
__device__ void s1_zin(const Params& p, int ti, float* lds) {
    const int w = threadIdx.x >> 6, lane = threadIdx.x & 63, fr = lane & 15, fq = lane >> 4, n0 = ti * 48, kw0 = w * 256;
    const bf16_t* A0 = (const bf16_t*)(p.ws + W_AALL) + (size_t)(TP + fr) * DM + fq * 8 + kw0; const bf16_t* B0 = (const bf16_t*)(p.ws + W_BTALL) + (size_t)(n0 + fr) * DM + fq * 8 + kw0;
    f32x4 acc[3][8];
#pragma unroll
    for (int nb = 0; nb < 3; ++nb)
#pragma unroll
        for (int rb = 0; rb < 8; ++rb) acc[nb][rb] = (f32x4){0.f, 0.f, 0.f, 0.f};
    skinny_k<3, 2>(acc, A0, DM, B0, (size_t)16 * DM, 8);
    bf16_t* Z = (bf16_t*)(p.ws + W_Z); const int row = TP + 16 * w + fr;
#pragma unroll
    for (int nb = 0; nb < 3; ++nb) { const f32x4 v = xwave_reduce(lds, acc[nb], w, lane);
        u32x2 o; o.x = cvt_pk_bf16(v[0], v[1]); o.y = cvt_pk_bf16(v[2], v[3]); *(u32x2*)(Z + (size_t)row * INW + n0 + nb * 16 + 4 * fq) = o; }
}
__device__ void s3_gates(const Params& p, int ti) {
    const int w = threadIdx.x >> 6, lane = threadIdx.x & 63, fr = lane & 15, fq = lane >> 4, row = TP + 16 * w + fr, h = ti >> 3, nb = ti & 7;
    const bf16_t* XR = (const bf16_t*)(p.ws + W_XR);
    const bf16_t* A = XR + (size_t)row * 1024 + (h & ~1) * 128 + fq * 8; const bf16_t* B = (const bf16_t*)(p.ws + W_WGT) + (size_t)(h * 256 + nb * 16 + fr) * 256 + fq * 8;
    f32x4 acc[2] = {{0.f, 0.f, 0.f, 0.f}, {0.f, 0.f, 0.f, 0.f}};
    skinny_acc<2>(acc, A, B, (size_t)128 * 256, 256);
    const int ch = h * 128 + nb * 16 + 4 * fq;
    const f32x4 vba = *(const f32x4*)(p.in[13] + ch), vbx = *(const f32x4*)(p.in[15] + ch), l = *(const f32x4*)(p.in[16] + ch);
    const u32x2 xw = *(const u32x2*)(XR + (size_t)row * 1024 + ch); const float xr[4] = {bf_lo(xw.x), bf_hi(xw.x), bf_lo(xw.y), bf_hi(xw.y)}; f32x4 av, uv;
#pragma unroll
    for (int j = 0; j < 4; ++j) { const float ex = fast_exp(-l[j]); const float sp = ex < 0.03f ? ex * (1.0f + ex * (-0.5f + ex * (0.33333333f - 0.25f * ex))) : __logf(1.0f + ex);
        const float r = sigmoidf_(acc[0][j] + vba[j]), ig = sigmoidf_(acc[1][j] + vbx[j]); const float la = -8.0f * sp * r;
        av[j] = fast_exp(la); uv[j] = __builtin_amdgcn_sqrtf(fmaxf(1.0f - fast_exp(2.0f * la), 0.f)) * ig * xr[j]; }
    *(f32x4*)((float*)(p.ws + W_SA) + (size_t)row * 1024 + ch) = av; *(f32x4*)((float*)(p.ws + W_SU) + (size_t)row * 1024 + ch) = uv;
}
__device__ void s5_merge(const Params& p, int ti, float* lds) {
    const int w = threadIdx.x >> 6, lane = threadIdx.x & 63, fr = lane & 15, fq = lane >> 4, n0 = ti * 16, col = n0 + 4 * fq, kw0 = w * 128;
    const bf16_t* Z = (const bf16_t*)(p.ws + W_Z);
    f32x4 m[8];
#pragma unroll
    for (int rb = 0; rb < 8; ++rb) m[rb] = (f32x4){0.f, 0.f, 0.f, 0.f};
#pragma unroll 1
    for (int j = 0; j < 3; ++j) {
        const bf16_t* A0 = (const bf16_t*)(p.ws + W_YCAT) + ((size_t)j * TPAD + TP + fr) * 1024 + fq * 8 + kw0; const bf16_t* B0 = (const bf16_t*)(p.ws + W_WBRT) + ((size_t)j * 2048 + n0 + fr) * 1024 + fq * 8 + kw0;
        f32x4 acc[1][8];
#pragma unroll
        for (int rb = 0; rb < 8; ++rb) acc[0][rb] = (f32x4){0.f, 0.f, 0.f, 0.f};
        u32x2 gw[8];
#pragma unroll
        for (int rb = 0; rb < 8; ++rb) gw[rb] = *(const u32x2*)(Z + (size_t)(TP + rb * 16 + fr) * INW + 6144 + j * 2048 + col);
        skinny_k<1, 4>(acc, A0, 1024, B0, 0, 4);
#pragma unroll
        for (int rb = 0; rb < 8; ++rb) { m[rb][0] += sigmoidf_(bf_lo(gw[rb].x)) * acc[0][rb][0]; m[rb][1] += sigmoidf_(bf_hi(gw[rb].x)) * acc[0][rb][1];
            m[rb][2] += sigmoidf_(bf_lo(gw[rb].y)) * acc[0][rb][2]; m[rb][3] += sigmoidf_(bf_hi(gw[rb].y)) * acc[0][rb][3]; }
    }
    const f32x4 v = xwave_reduce(lds, m, w, lane);
    u32x2 o; o.x = cvt_pk_bf16(v[0], v[1]); o.y = cvt_pk_bf16(v[2], v[3]); *(u32x2*)((bf16_t*)(p.ws + W_MB) + (size_t)(TP + 16 * w + fr) * DM + col) = o;
}
__device__ void s68_plain(const Params& p, int ti, size_t wA, size_t wB, float* outF, bf16_t* outB, float* lds) {
    const int w = threadIdx.x >> 6, lane = threadIdx.x & 63, fr = lane & 15, fq = lane >> 4, n0 = ti * 16, col = n0 + 4 * fq, kw0 = w * 256;
    const bf16_t* A0 = (const bf16_t*)(p.ws + wA) + (size_t)(TP + fr) * DM + fq * 8 + kw0; const bf16_t* B0 = (const bf16_t*)(p.ws + wB) + (size_t)(n0 + fr) * DM + fq * 8 + kw0;
    f32x4 acc[1][8];
#pragma unroll
    for (int rb = 0; rb < 8; ++rb) acc[0][rb] = (f32x4){0.f, 0.f, 0.f, 0.f};
    skinny_k<1, 4>(acc, A0, DM, B0, 0, 8);
    const f32x4 v = xwave_reduce(lds, acc[0], w, lane); const int row = TP + 16 * w + fr;
    if (outF) *(f32x4*)(outF + (size_t)row * DM + col) = v;
    else { u32x2 o; o.x = cvt_pk_bf16(v[0], v[1]); o.y = cvt_pk_bf16(v[2], v[3]); *(u32x2*)(outB + (size_t)row * DM + col) = o; }
}
__device__ void s9_scores(const Params& p, int ti) {
    const int w = threadIdx.x >> 6, lane = threadIdx.x & 63, fr = lane & 15, fq = lane >> 4, row = TP + 16 * w + fr, h = ti >> 3, nbp = ti & 7;
    const bf16_t* A = (const bf16_t*)(p.ws + W_QP) + (size_t)row * DM + h * 256 + fq * 8; const bf16_t* B = (const bf16_t*)(p.ws + W_WKT) + (size_t)(h * 256 + nbp * 32 + fr) * 256 + fq * 8;
    f32x4 acc[2] = {{0.f, 0.f, 0.f, 0.f}, {0.f, 0.f, 0.f, 0.f}};
    skinny_acc<2>(acc, A, B, (size_t)16 * 256, 256);
    float* SC = (float*)(p.ws + W_SC) + (size_t)row * DM + h * 256 + nbp * 32 + 4 * fq;
    *(f32x4*)SC = acc[0]; *(f32x4*)(SC + 16) = acc[1];
}

__device__ void p4a(const Params& p) {
    const float* SA = (const float*)(p.ws + W_SA); const float* SU = (const float*)(p.ws + W_SU); float* CA = (float*)(p.ws + W_CHK); float* CH = CA + 4 * 32 * 1024;
    for (int idx = blockIdx.x * 512 + threadIdx.x; idx < 4 * 32 * 1024; idx += gridDim.x * 512) {
        const int ch = idx & 1023, chunk = (idx >> 10) & 31, b = idx >> 15; const size_t base = ((size_t)b * 2048 + chunk * 64) * 1024 + ch;
        float A = 1.f, H = 0.f;
#pragma unroll 8
        for (int s = 0; s < 64; ++s) { const float a = SA[base + (size_t)s * 1024], u = SU[base + (size_t)s * 1024]; H = a * H + u; A *= a; }
        CA[idx] = A; CH[idx] = H;
    }
}
__device__ void p4b(const Params& p) {
    const float* __restrict__ SA = (const float*)(p.ws + W_SA); const float* __restrict__ SU = (const float*)(p.ws + W_SU); const float* __restrict__ CA = (const float*)(p.ws + W_CHK); const float* __restrict__ CH = CA + 4 * 32 * 1024;
    const bf16_t* __restrict__ Z = (const bf16_t*)(p.ws + W_Z); bf16_t* __restrict__ Y1 = (bf16_t*)(p.ws + W_YCAT) + (size_t)TPAD * 1024;
    const int nprompt = 4 * 32 * 1024, ntot = nprompt + TS * 1024;
    for (int idx = blockIdx.x * 512 + threadIdx.x; idx < ntot; idx += gridDim.x * 512) {
        if (idx < nprompt) {
            const int ch = idx & 1023, chunk = (idx >> 10) & 31, b = idx >> 15;
            float h = 0.f;
#pragma unroll 1
            for (int j0 = 0; j0 < chunk; j0 += 8) {
                float ca[8], chh[8];
#pragma unroll
                for (int e = 0; e < 8; ++e) { const int jj = min(j0 + e, 31), q = ((b * 32 + jj) << 10) + ch; ca[e] = CA[q]; chh[e] = CH[q]; }
#pragma unroll
                for (int e = 0; e < 8; ++e) if (j0 + e < chunk) h = ca[e] * h + chh[e];
            }
            const size_t t0 = (size_t)b * 2048 + chunk * 64;
#pragma unroll 1
            for (int s0 = 0; s0 < 64; s0 += 16) {
                float a[16], u[16], rg[16];
#pragma unroll
                for (int s = 0; s < 16; ++s) { const size_t t = t0 + s0 + s; a[s] = SA[t * 1024 + ch]; u[s] = SU[t * 1024 + ch]; rg[s] = bf1(Z[t * INW + 4096 + ch]); }
#pragma unroll
                for (int s = 0; s < 16; ++s) { h = a[s] * h + u[s]; Y1[(t0 + s0 + s) * 1024 + ch] = f2bf(h * gelu_tanh(rg[s])); }
            }
            if (chunk == 31) p.out[O_HP + (size_t)b * 1024 + ch] = h;
        } else {
            const int j = idx - nprompt, ch = j & 1023, bs = j >> 10; const size_t t = TP + bs;
            const float h = SA[t * 1024 + ch] * p.in[7][(size_t)bs * 1024 + ch] + SU[t * 1024 + ch];
            p.out[O_HS + (size_t)bs * 1024 + ch] = h;
            const float rg = bf1(Z[t * INW + 4096 + ch]); Y1[t * 1024 + ch] = f2bf(h * gelu_tanh(rg));
        }
    }
}


__device__ void p4a_tile(const Params& p, int pm, int h) {
    const float* SA = (const float*)(p.ws + W_SA); const float* SU = (const float*)(p.ws + W_SU); float* CA = (float*)(p.ws + W_CHK); float* CH = CA + 4 * 32 * 1024;
    const int ch = h * 128 + (threadIdx.x & 127), row0 = pm * 256 + (threadIdx.x >> 7) * 64, b = row0 >> 11, chunk = (row0 & 2047) >> 6;
    const size_t base = (size_t)row0 * 1024 + ch;
    float A = 1.f, H = 0.f;
#pragma unroll 1
    for (int s0 = 0; s0 < 64; s0 += 16) { float a[16], u[16];
#pragma unroll
        for (int s2 = 0; s2 < 16; ++s2) { a[s2] = SA[base + (size_t)(s0 + s2) * 1024]; u[s2] = SU[base + (size_t)(s0 + s2) * 1024]; }
#pragma unroll
        for (int s2 = 0; s2 < 16; ++s2) { H = a[s2] * H + u[s2]; A *= a[s2]; } }
    const int idx = ((b * 32 + chunk) << 10) + ch; CA[idx] = A; CH[idx] = H;
}
__device__ void s9_full(const Params& p, int h) {
    const int w = threadIdx.x >> 6, lane = threadIdx.x & 63, fr = lane & 15, fq = lane >> 4, row = TP + 16 * w + fr;
    const bf16_t* A = (const bf16_t*)(p.ws + W_QP) + (size_t)row * DM + h * 256 + fq * 8; float* SC = (float*)(p.ws + W_SC) + (size_t)row * DM + h * 256 + 4 * fq;
#pragma unroll 1
    for (int g4 = 0; g4 < 4; ++g4) {
        const bf16_t* B = (const bf16_t*)(p.ws + W_WKT) + (size_t)(h * 256 + g4 * 64 + fr) * 256 + fq * 8;
        f32x4 acc[4] = {{0.f, 0.f, 0.f, 0.f}, {0.f, 0.f, 0.f, 0.f}, {0.f, 0.f, 0.f, 0.f}, {0.f, 0.f, 0.f, 0.f}};
        skinny_acc<4>(acc, A, B, (size_t)16 * 256, 256);
#pragma unroll
        for (int nb = 0; nb < 4; ++nb) *(f32x4*)(SC + g4 * 64 + nb * 16) = acc[nb];
    }
}

__device__ void p7(const Params& p, float* lds) {
    const float* H1 = (const float*)(p.ws + W_H1); bf16_t* X1B = (bf16_t*)(p.ws + W_X1B);
    const int lane = threadIdx.x & 63, w = threadIdx.x >> 6, gw = blockIdx.x * 8 + w, nw = gridDim.x * 8;
    for (int row = gw; row < TP; row += nw) {
        f32x4 v[8]; float s = 0.f; const float* xrow = p.in[0] + (size_t)row * DM;
#pragma unroll
        for (int j = 0; j < 8; ++j) { v[j] = *(const f32x4*)(H1 + (size_t)row * DM + j * 256 + lane * 4) + *(const f32x4*)(xrow + j * 256 + lane * 4) * DN_ALPHA; s += v[j][0] + v[j][1] + v[j][2] + v[j][3]; }
        const float mean = wave_sum(s) * (1.0f / DM); float q = 0.f;
#pragma unroll
        for (int j = 0; j < 8; ++j) { v[j] -= mean; q += v[j][0] * v[j][0] + v[j][1] * v[j][1] + v[j][2] * v[j][2] + v[j][3] * v[j][3]; }
        const float rstd = rsqrtf(wave_sum(q) * (1.0f / DM) + LN_EPS);
#pragma unroll
        for (int j = 0; j < 8; ++j) { const int c = j * 256 + lane * 4; const f32x4 g = *(const f32x4*)(p.in[23] + c), bb = *(const f32x4*)(p.in[24] + c);
            const f32x4 y = v[j] * rstd * g + bb;
            u32x2 wd; wd.x = cvt_pk_bf16(y[0], y[1]); wd.y = cvt_pk_bf16(y[2], y[3]); *(u32x2*)(X1B + (size_t)row * DM + c) = wd; }
    }
    for (int r = blockIdx.x; r < TS; r += gridDim.x) {
        const int row = TP + r, c = w * 256 + lane * 4;
        f32x4 v = *(const f32x4*)(H1 + (size_t)row * DM + c) + *(const f32x4*)(p.in[1] + (size_t)r * DM + c) * DN_ALPHA;
        const float s = wave_sum(v[0] + v[1] + v[2] + v[3]);
        __syncthreads();
        if (lane == 0) lds[w] = s;
        __syncthreads();
        float tot = 0.f;
#pragma unroll
        for (int ww = 0; ww < 8; ++ww) tot += lds[ww];
        v -= tot * (1.0f / DM);
        const float q = wave_sum(v[0] * v[0] + v[1] * v[1] + v[2] * v[2] + v[3] * v[3]);
        if (lane == 0) lds[8 + w] = q;
        __syncthreads();
        float qt = 0.f;
#pragma unroll
        for (int ww = 0; ww < 8; ++ww) qt += lds[8 + ww];
        const float rstd = rsqrtf(qt * (1.0f / DM) + LN_EPS);
        const f32x4 g = *(const f32x4*)(p.in[23] + c), bb = *(const f32x4*)(p.in[24] + c); const f32x4 y = v * rstd * g + bb;
        u32x2 wd; wd.x = cvt_pk_bf16(y[0], y[1]); wd.y = cvt_pk_bf16(y[2], y[3]); *(u32x2*)(X1B + (size_t)row * DM + c) = wd;
    }
}

__device__ __forceinline__ unsigned ord_key(float f) { const unsigned u = __float_as_uint(f); return (u & 0x80000000u) ? ~u : (u | 0x80000000u); }
__device__ __forceinline__ float ord_val(unsigned k) { return __uint_as_float((k & 0x80000000u) ? (k & 0x7fffffffu) : ~k); }

#define CE_DESC(a, b) do { const unsigned mx_ = max(a, b), mn_ = min(a, b); a = mx_; b = mn_; } while (0)
__device__ void p9b(const Params& p, int mode) {
    const float* SC = (const float*)(p.ws + W_SC); u32x4* PICKS = (u32x4*)(p.ws + W_PICKS); const float* SCU = (const float*)(p.ws + W_SCU); const float* SCV = (const float*)(p.ws + W_SCV);
    const int nitem = TT * 16, gid = blockIdx.x * 512 + threadIdx.x, gth = gridDim.x * 512;
    int pm1 = 0, h1 = 0; if (mode == 1) std_tile((int)blockIdx.x, 32, 8, pm1, h1);
    const bool fast = (mode == 0 && gth == TP * 16);
    const int npass = (mode == 1 || fast) ? 2 : (nitem + gth - 1) / gth;
#pragma unroll 1
    for (int pass_ = 0; pass_ < npass; ++pass_) {
        int item = gid + pass_ * gth;
        if (mode == 1) { const int tt = pass_ == 0 ? pm1 * 256 + (int)(threadIdx.x >> 1) : TP + (int)(threadIdx.x >> 1), hh = pass_ == 0 ? h1 : (int)blockIdx.x;
            item = (pass_ == 0 || (blockIdx.x < 8 && threadIdx.x < 256)) ? ((tt * 8 + hh) << 1) + (int)(threadIdx.x & 1) : nitem; }
        if (fast && pass_ == 1) item = (threadIdx.x < 64 && blockIdx.x < 32) ? TP * 16 + (int)blockIdx.x * 64 + (int)threadIdx.x : nitem;
        if (item >= nitem) continue;
        const int c = item & 1, th = item >> 1, t = th >> 3, h = th & 7;
        const float* sp = SC + (size_t)t * DM + h * 256 + c * 128;
        unsigned key[128];
#pragma unroll
        for (int i = 0; i < 32; ++i) { const f32x4 v = *(const f32x4*)(sp + i * 4);
#pragma unroll
            for (int e = 0; e < 4; ++e) key[i * 4 + e] = (ord_key(v[e]) & 0xffffff80u) | (unsigned)(127 - (i * 4 + e)); }
#pragma unroll
        for (int gq = 0; gq < 8; ++gq)
#pragma unroll
            for (int k = 2; k <= 16; k <<= 1)
#pragma unroll
                for (int j = k >> 1; j > 0; j >>= 1)
#pragma unroll
                    for (int i = 0; i < 16; ++i) { const int l = i ^ j; if (l > i) { if ((i & k) == 0) CE_DESC(key[gq * 16 + i], key[gq * 16 + l]); else CE_DESC(key[gq * 16 + l], key[gq * 16 + i]); } }
#pragma unroll
        for (int span = 1; span < 8; span <<= 1)
#pragma unroll
            for (int gq = 0; gq < 8; gq += 2 * span) {
#pragma unroll
                for (int i = 0; i < 16; ++i) key[gq * 16 + i] = max(key[gq * 16 + i], key[(gq + span) * 16 + 15 - i]);
#pragma unroll
                for (int j = 8; j > 0; j >>= 1)
#pragma unroll
                    for (int i = 0; i < 16; ++i) { const int l = i ^ j; if (l > i) CE_DESC(key[gq * 16 + i], key[gq * 16 + l]); }
            }
        unsigned top[16];
#pragma unroll
        for (int q = 0; q < 16; ++q) top[q] = key[q];
        float sm[16], so[16]; int im[16], io[16];
#pragma unroll
        for (int q = 0; q < 16; ++q) { sm[q] = ord_val(top[q] & 0xffffff80u); im[q] = 127 - (int)(top[q] & 127u); so[q] = __shfl_xor(sm[q], 1, 64); io[q] = __shfl_xor(im[q], 1, 64); }
        float s1[16], s2[16]; int i1[16], i2[16];
#pragma unroll
        for (int q = 0; q < 16; ++q) { s1[q] = c ? so[q] : sm[q]; s2[q] = c ? sm[q] : so[q]; i1[q] = c ? io[q] : im[q]; i2[q] = c ? im[q] : io[q]; }
        unsigned ck[50]; int nc = 0;
#pragma unroll
        for (int i = 0; i < 16; ++i)
#pragma unroll
            for (int j = 0; j < 16; ++j) if ((i + 1) * (j + 1) <= 16) { ck[nc] = (ord_key(s1[i] + s2[j]) & 0xffffff00u) | (unsigned)(255 - (i * 16 + j)); ++nc; }
        unsigned c64[64];
#pragma unroll
        for (int i = 0; i < 64; ++i) c64[i] = (i < 50) ? ck[i] : 0u;
#pragma unroll
        for (int gq = 0; gq < 4; ++gq)
#pragma unroll
            for (int k = 2; k <= 16; k <<= 1)
#pragma unroll
                for (int j = k >> 1; j > 0; j >>= 1)
#pragma unroll
                    for (int i = 0; i < 16; ++i) { const int l = i ^ j; if (l > i) { if ((i & k) == 0) CE_DESC(c64[gq * 16 + i], c64[gq * 16 + l]); else CE_DESC(c64[gq * 16 + l], c64[gq * 16 + i]); } }
#pragma unroll
        for (int span = 1; span < 4; span <<= 1)
#pragma unroll
            for (int gq = 0; gq < 4; gq += 2 * span) {
#pragma unroll
                for (int i = 0; i < 16; ++i) c64[gq * 16 + i] = max(c64[gq * 16 + i], c64[(gq + span) * 16 + 15 - i]);
#pragma unroll
                for (int j = 8; j > 0; j >>= 1)
#pragma unroll
                    for (int i = 0; i < 16; ++i) { const int l = i ^ j; if (l > i) CE_DESC(c64[gq * 16 + i], c64[gq * 16 + l]); }
            }
        unsigned ct[16];
#pragma unroll
        for (int q = 0; q < 16; ++q) ct[q] = c64[q];
        const float vmax = ord_val(ct[0] & 0xffffff00u); float ev[16], esum = 0.f;
#pragma unroll
        for (int q = 0; q < 16; ++q) { ev[q] = fast_exp(ord_val(ct[q] & 0xffffff00u) - vmax); esum += ev[q]; }
        const float einv = 1.0f / esum;
#pragma unroll
        for (int q = 0; q < 8; ++q) {
            const unsigned cm = (unsigned)(-c);
            const unsigned kk = ct[2 * q] ^ ((ct[2 * q] ^ ct[2 * q + 1]) & cm);
            const unsigned eb0 = __float_as_uint(ev[2 * q]), eb1 = __float_as_uint(ev[2 * q + 1]);
            const float gwt = __uint_as_float(eb0 ^ ((eb0 ^ eb1) & cm)) * einv;
            const int cid = 255 - (int)(kk & 255u), ci = cid >> 4, cj = cid & 15;
            int e1 = 0, e2 = 0;
#pragma unroll
            for (int r = 0; r < 16; ++r) { e1 = (ci == r) ? i1[r] : e1; e2 = (cj == r) ? i2[r] : e2; }
            const int ex = e1 * 128 + e2;
            u32x4 pk; pk.x = (unsigned)ex; pk.y = __float_as_uint(gwt * SCV[ex]); pk.z = __float_as_uint(SCU[ex]); pk.w = 0u;
            PICKS[(size_t)t * 128 + h * 16 + 2 * q + c] = pk;
        }
    }
}

__device__ void p10(const Params& p, float* lds) {
    const bf16_t* X1B = (const bf16_t*)(p.ws + W_X1B); const u32x4* PICKS = (const u32x4*)(p.ws + W_PICKS);
    const unsigned char* U8 = p.ws + W_UB; const unsigned char* V8 = p.ws + W_VB;
    const int w = threadIdx.x >> 6, lane = threadIdx.x & 63;
    for (int t = blockIdx.x; t < TT; t += gridDim.x) {
        f32x2 xe[2][8];
#pragma unroll
        for (int j = 0; j < 2; ++j)
#pragma unroll
            for (int q = 0; q < 2; ++q) { const u32x4 v = *(const u32x4*)(X1B + (size_t)t * DM + j * 1024 + lane * 16 + q * 8);
                xe[j][4 * q] = (f32x2){bf_lo(v.x), bf_hi(v.x)}; xe[j][4 * q + 1] = (f32x2){bf_lo(v.y), bf_hi(v.y)}; xe[j][4 * q + 2] = (f32x2){bf_lo(v.z), bf_hi(v.z)}; xe[j][4 * q + 3] = (f32x2){bf_lo(v.w), bf_hi(v.w)}; }
        const u32x4 mypick = PICKS[(size_t)t * 128 + w * 16 + (lane & 15)];
        f32x2 y[2][8];
#pragma unroll
        for (int j = 0; j < 2; ++j)
#pragma unroll
            for (int e = 0; e < 8; ++e) y[j][e] = (f32x2){0.f, 0.f};
#pragma unroll 1
        for (int k = 0; k < 16; k += 8) {
            u32x4 uw[8][2], vw[8][2]; float cvv[8], suu[8];
#pragma unroll
            for (int g = 0; g < 8; ++g) {
                const unsigned e = (unsigned)__builtin_amdgcn_readlane((int)mypick.x, k + g) & 16383u;
                cvv[g] = __uint_as_float((unsigned)__builtin_amdgcn_readlane((int)mypick.y, k + g)); suu[g] = __uint_as_float((unsigned)__builtin_amdgcn_readlane((int)mypick.z, k + g));
                const unsigned char* up = U8 + (size_t)e * 2048 + lane * 16; const unsigned char* vp = V8 + (size_t)e * 2048 + lane * 16;
                uw[g][0] = *(const u32x4*)up; uw[g][1] = *(const u32x4*)(up + 1024); vw[g][0] = *(const u32x4*)vp; vw[g][1] = *(const u32x4*)(vp + 1024);
            }
#pragma unroll
            for (int g = 0; g < 8; ++g) {
                f32x2 d2 = (f32x2){0.f, 0.f};
#pragma unroll
                for (int j = 0; j < 2; ++j)
#pragma unroll
                    for (int q = 0; q < 4; ++q) { const int wd = (int)uw[g][j][q];
                        d2 += __builtin_amdgcn_cvt_pk_f32_fp8(wd, false) * xe[j][2 * q]; d2 += __builtin_amdgcn_cvt_pk_f32_fp8(wd, true) * xe[j][2 * q + 1]; }
                const float d = wave_sum(d2[0] + d2[1]);
                const float cf = cvv[g] * gelu_tanh(d * suu[g]);
#pragma unroll
                for (int j = 0; j < 2; ++j)
#pragma unroll
                    for (int q = 0; q < 4; ++q) { const int wd = (int)vw[g][j][q];
                        y[j][2 * q] += __builtin_amdgcn_cvt_pk_f32_fp8(wd, false) * cf; y[j][2 * q + 1] += __builtin_amdgcn_cvt_pk_f32_fp8(wd, true) * cf; }
            }
        }
#pragma unroll
        for (int j = 0; j < 2; ++j)
#pragma unroll
            for (int q = 0; q < 4; ++q) *(f32x4*)(lds + w * 2048 + j * 1024 + lane * 16 + q * 4) = (f32x4){y[j][2 * q][0], y[j][2 * q][1], y[j][2 * q + 1][0], y[j][2 * q + 1][1]};
        __syncthreads();
        {
            const int c0 = threadIdx.x * 4; f32x4 acc = *(const f32x4*)(lds + c0);
#pragma unroll
            for (int ww = 1; ww < 8; ++ww) acc += *(const f32x4*)(lds + ww * 2048 + c0);
            const u32x2 xw = *(const u32x2*)(X1B + (size_t)t * DM + c0); const f32x4 xv = (f32x4){bf_lo(xw.x), bf_hi(xw.x), bf_lo(xw.y), bf_hi(xw.y)};
            f32x4 r = xv * DN_ALPHA + acc;
            float s = wave_sum(r[0] + r[1] + r[2] + r[3]);
            if (lane == 0) lds[16384 + w] = s;
            __syncthreads();
            float tot = 0.f;
#pragma unroll
            for (int ww = 0; ww < 8; ++ww) tot += lds[16384 + ww];
            const float mean = tot * (1.0f / DM); r -= mean;
            float q = wave_sum(r[0] * r[0] + r[1] * r[1] + r[2] * r[2] + r[3] * r[3]);
            if (lane == 0) lds[16400 + w] = q;
            __syncthreads();
            float qt = 0.f;
#pragma unroll
            for (int ww = 0; ww < 8; ++ww) qt += lds[16400 + ww];
            const float rstd = rsqrtf(qt * (1.0f / DM) + LN_EPS);
            const f32x4 g = *(const f32x4*)(p.in[29] + c0), bb = *(const f32x4*)(p.in[30] + c0);
            *(f32x4*)(p.out + O_Y + (size_t)t * DM + c0) = r * rstd * g + bb;
        }
        __syncthreads();
    }
}


#ifdef DBG_DUMP
__device__ void dbg_dump(const Params& p) {
    const bf16_t* src = (const bf16_t*)(p.ws + DBG_DUMP_OFF);
    for (size_t i = (size_t)blockIdx.x * 512 + threadIdx.x; i < (size_t)TT * 1024; i += (size_t)gridDim.x * 512) {
        if (DBG_LAST <= 2 && i < 19947520 - O_CZP) p.out[O_CZP + i] = 0.f;
        const size_t r = i >> 10, c = i & 1023; p.out[O_Y + r * DM + c] = (r < TP) ? bf1(src[r * DBG_DUMP_LD + c]) : 0.f; p.out[O_Y + r * DM + 1024 + c] = 0.f; }
}
#endif

__device__ __forceinline__ void grid_bar(unsigned* words, unsigned n) {
    asm volatile("s_waitcnt vmcnt(0) lgkmcnt(0)" ::: "memory");
    __syncthreads();
    if (threadIdx.x == 0) {
        const unsigned G = gridDim.x, grp = blockIdx.x & 7u, gs = (G - grp + 7u) >> 3, ngrp = G < 8u ? G : 8u;
        __builtin_amdgcn_fence(__ATOMIC_RELEASE, "agent");
        const unsigned old = __hip_atomic_fetch_add(words + 32 * (1 + grp), 1u, __ATOMIC_RELAXED, __HIP_MEMORY_SCOPE_AGENT);
        if (old + 1u == n * gs) __hip_atomic_fetch_add(words, 1u, __ATOMIC_RELAXED, __HIP_MEMORY_SCOPE_AGENT);
        while (__hip_atomic_load(words, __ATOMIC_RELAXED, __HIP_MEMORY_SCOPE_AGENT) < n * ngrp) __builtin_amdgcn_s_sleep(1);
        __builtin_amdgcn_fence(__ATOMIC_ACQUIRE, "agent");
        asm volatile("s_waitcnt vmcnt(0)" ::: "memory");
    }
    __syncthreads();
}
extern __shared__ __attribute__((aligned(16))) unsigned char smem_raw[];

__global__ void __launch_bounds__(512, 2) fwd_kernel(Params p) {
    LAS unsigned char* lds = (LAS unsigned char*)smem_raw;
    float* ldsf = (float*)smem_raw;
    unsigned char* ws = p.ws;
    const int G = gridDim.x, c = blockIdx.x;
#ifndef ONLY_PH
#define ONLY_PH -1
#endif
    unsigned* barw = (unsigned*)(ws + W_BAR); unsigned nbar = 0;
#define UCONV(R0, R1) if (c >= G / 2) cvt_fp8_rows(p.in[27] + (size_t)(R0) * 2048, ws + W_UB + (size_t)(R0) * 2048, (float*)(ws + W_SCU) + (R0), (R1) - (R0), (c - G / 2) * 8 + (int)(threadIdx.x >> 6), (G - G / 2) * 8)
#define RUNPH_NB(n, ...) if ((ONLY_PH < 0 || ONLY_PH == (n)) && p.ph_lo <= (n) && (n) < p.ph_hi) { __VA_ARGS__; }
#define RUNPH(n, ...) if ((ONLY_PH < 0 || ONLY_PH == (n)) && p.ph_lo <= (n) && (n) < p.ph_hi) { __VA_ARGS__; if ((n) + 1 < p.ph_hi) { ++nbar; grid_bar(barw, nbar); } }
    RUNPH(0, phase0(p, ldsf))
    RUNPH(1, { Gemm g{(const bf16_t*)(ws + W_AALL), (const bf16_t*)(ws + W_BTALL), 2048, 2048, 2048};
            Epi1 e{(bf16_t*)(ws + W_Z), p.out + O_MK, p.out + O_MV, (bf16_t*)(ws + W_MKB), (bf16_t*)(ws + W_VTB)};
            SchedGrid s{32, 48, G, c, 0}; gemm_phase(lds, g, s, e);
            for (int ti = c; ti < 256; ti += G) s1_zin(p, ti, ldsf); })
    RUNPH(2, { const int nmk = G > 64 ? 32 : 0;
            if (c < nmk || nmk == 0) { Gemm g{(const bf16_t*)(ws + W_AALL), (const bf16_t*)(ws + W_BTALL), 2048, 2048, 2048};
                Epi1 e{(bf16_t*)(ws + W_Z), p.out + O_MK, p.out + O_MV, (bf16_t*)(ws + W_MKB), (bf16_t*)(ws + W_VTB)};
                SchedMKV s{nmk ? nmk : G, c}; gemm_phase(lds, g, s, e); }
            if (c >= nmk) for (int it = c - nmk; it < 672; it += G - nmk) {
                if (it < 512) p2_attn_sample(p, it, ldsf);
                else if (it < 640) p2_elem_prompt(p, it - 512);
                else p2_elem_sample(p, it - 640);
            }
            if (c >= nmk) cvt_fp8_rows(p.in[28], ws + W_VB, (float*)(ws + W_SCV), 16384, (c - nmk) * 8 + (int)(threadIdx.x >> 6), (G - nmk) * 8); })
    RUNPH(3, { Gemm g{(const bf16_t*)(ws + W_XR), (const bf16_t*)(ws + W_WGT), 1024, 256, 256};
            Epi3 e{(const bf16_t*)(ws + W_XR), (float*)(ws + W_SA), (float*)(ws + W_SU), p.in[13], p.in[15], p.in[16]};
            SchedGrid s{32, 8, G, c, 1}; gemm_phase(lds, g, s, e);
            for (int ti = c; ti < 64; ti += G) s3_gates(p, ti);
            if (G == 256) { int pm_, pn_; std_tile(c, 32, 8, pm_, pn_); asm volatile("s_waitcnt vmcnt(0)" ::: "memory"); __syncthreads(); p4a_tile(p, pm_, pn_); }
            for (int it = c; it < 256; it += G) p2_attn_prompt(p, it); })
    if (G != 256) { RUNPH(4, p4a(p)) }
    RUNPH(5, p4b(p))
    RUNPH(6, { Gemm g{(const bf16_t*)(ws + W_YCAT), (const bf16_t*)(ws + W_WBRT), 1024, 1024, 1024};
            Epi5 e{(const bf16_t*)(ws + W_Z), (bf16_t*)(ws + W_MF), (bf16_t*)(ws + W_MF) + (size_t)TPAD * DM, (bf16_t*)(ws + W_MB)};
            Sched5 s{G, c}; gemm_phase(lds, g, s, e);
            for (int ti = c; ti < 128; ti += G) s5_merge(p, ti, ldsf);
            UCONV(0, 5461); })
    RUNPH(7, { Gemm g{(const bf16_t*)(ws + W_MB), (const bf16_t*)(ws + W_WOT), 2048, 2048, 2048};
            EpiF e{(float*)(ws + W_H1), 2048};
            SchedGrid s{32, 8, G, c, 0}; gemm_phase(lds, g, s, e);
            for (int ti = c; ti < 128; ti += G) s68_plain(p, ti, W_MB, W_WOT, (float*)(ws + W_H1), nullptr, ldsf);
            UCONV(5461, 10922); })
    RUNPH(8, p7(p, ldsf))
    RUNPH(9, { Gemm g{(const bf16_t*)(ws + W_X1B), (const bf16_t*)(ws + W_WQT), 2048, 2048, 2048};
            EpiB e{(bf16_t*)(ws + W_QP), 2048};
            SchedGrid s{32, 8, G, c, 0}; gemm_phase(lds, g, s, e);
            for (int ti = c; ti < 128; ti += G) s68_plain(p, ti, W_X1B, W_WQT, nullptr, (bf16_t*)(ws + W_QP), ldsf);
            UCONV(10922, 16384); })
    RUNPH_NB(10, { Gemm g{(const bf16_t*)(ws + W_QP), (const bf16_t*)(ws + W_WKT), 2048, 256, 256};
            EpiF e{(float*)(ws + W_SC), 2048};
            SchedGrid s{32, 8, G, c, 2}; gemm_phase(lds, g, s, e);
            for (int ti = c; ti < 64; ti += G) s9_scores(p, ti); })
    if (p.ph_lo <= 10 && 11 < p.ph_hi) { ++nbar; grid_bar(barw, nbar); }
    RUNPH(11, p9b(p, 0))
    RUNPH(12, p10(p, ldsf))
    if (p.ph_hi > 4096) cg::this_grid().sync();
#ifdef DBG_DUMP
    RUNPH(13, dbg_dump(p))
#endif
}

#ifndef N_LAUNCH_PER_PHASE
#define N_LAUNCH_PER_PHASE 0
#endif

extern "C" void kernel_launch(void* const* d_in, const int* in_sizes, int n_in, void* d_out, int out_size, void* d_ws, size_t ws_size, hipStream_t stream) {
    constexpr int LDS_BYTES = STAGE_BYTES;
    static int grid = 0;
    if (grid == 0) {
        if (n_in != 31 || ws_size < W_END) { fprintf(stderr, "kernel_launch: unexpected n_in %d / ws_size %zu (need %zu)\n", n_in, ws_size, (size_t)W_END); grid = -1; return; }
        int dev = 0, cus = 0, per_cu = 0;
        hipGetDevice(&dev); hipDeviceGetAttribute(&cus, hipDeviceAttributeMultiprocessorCount, dev);
        if (hipFuncSetAttribute((const void*)fwd_kernel, hipFuncAttributeMaxDynamicSharedMemorySize, LDS_BYTES) != hipSuccess) { fprintf(stderr, "hipFuncSetAttribute failed\n"); grid = -1; return; }
        if (hipOccupancyMaxActiveBlocksPerMultiprocessor(&per_cu, (const void*)fwd_kernel, 512, LDS_BYTES) != hipSuccess || per_cu < 1) { fprintf(stderr, "occupancy query failed (%d)\n", per_cu); per_cu = 1; }
        (void)hipGetLastError();
        grid = cus * (per_cu > 1 ? 1 : per_cu);
    }
    if (grid < 0) return;
    Params p{};
    for (int i = 0; i < 31; ++i) p.in[i] = (const float*)d_in[i];
    p.out = (float*)d_out; p.ws = (unsigned char*)d_ws;
#if N_LAUNCH_PER_PHASE
    #ifdef DBG_DUMP
    for (int ph = 0; ph < DBG_LAST; ++ph) { p.ph_lo = ph; p.ph_hi = ph + 1; hipLaunchKernelGGL(fwd_kernel, dim3(grid), dim3(512), LDS_BYTES, stream, p); }
    p.ph_lo = 13; p.ph_hi = 14; hipLaunchKernelGGL(fwd_kernel, dim3(grid), dim3(512), LDS_BYTES, stream, p);
#else
    for (int ph = 0; ph < NPH; ++ph) { p.ph_lo = ph; p.ph_hi = ph + 1; hipLaunchKernelGGL(fwd_kernel, dim3(grid), dim3(512), LDS_BYTES, stream, p); }
#endif
#else
    p.ph_lo = 0; p.ph_hi = NPH;
    (void)hipMemsetAsync((char*)d_ws + W_BAR, 0, 2048, stream);
    void* args[] = {&p};
    hipError_t e = hipLaunchCooperativeKernel((const void*)fwd_kernel, dim3(grid), dim3(512), args, LDS_BYTES, stream);
    if (e != hipSuccess) fprintf(stderr, "cooperative launch failed: %s (grid %d)\n", hipGetErrorString(e), grid);
#endif
}
```

```cpp
#define DBG_DUMP_OFF (W_YCAT + (size_t)2 * TPAD * 1024 * 2)
#define DBG_DUMP_LD 1024
#define DBG_LAST 6
#define REPMASK 0
#include <hip/hip_runtime.h>
#include <hip/hip_cooperative_groups.h>
#include <cstdio>
namespace cg = cooperative_groups;

#define LAS __attribute__((address_space(3)))
typedef unsigned short bf16_t;
typedef short bf16x8 __attribute__((ext_vector_type(8)));
typedef float f32x4 __attribute__((ext_vector_type(4)));
typedef float f32x2 __attribute__((ext_vector_type(2)));
typedef unsigned u32x4 __attribute__((ext_vector_type(4)));
typedef unsigned u32x2 __attribute__((ext_vector_type(2)));

constexpr int DM = 2048, TP = 8192, TS = 128, TT = 8320, TPAD = 8448, NMEM = 1024, INW = 12288;
constexpr int NPH = 13;
constexpr float DN_ALPHA = 1.189207115002721f;
constexpr float LN_EPS = 1e-5f;
constexpr size_t O_Y = 0, O_MK = 17039360, O_MV = 18087936, O_CZP = 19136512, O_RCP = 19144704, O_HP = 19156992,
                 O_CZS = 19161088, O_RCS = 19423232, O_HS = 19816448;
constexpr size_t al256(size_t x) { return (x + 255) & ~(size_t)255; }
constexpr size_t W_AALL = 0;
constexpr size_t W_BTALL = W_AALL + (size_t)9472 * 2048 * 2;
constexpr size_t W_WBRT = W_BTALL + (size_t)14336 * 2048 * 2;
constexpr size_t W_WOT = W_WBRT + (size_t)3 * 2048 * 1024 * 2;
constexpr size_t W_WQT = W_WOT + (size_t)2048 * 2048 * 2;
constexpr size_t W_WGT = W_WQT + (size_t)2048 * 2048 * 2;
constexpr size_t W_WKT = W_WGT + (size_t)2048 * 256 * 2;
constexpr size_t W_UB = W_WKT + (size_t)2048 * 256 * 2;
constexpr size_t W_VB = W_UB + (size_t)16384 * 2048 * 2;
constexpr size_t W_Z = W_VB + (size_t)16384 * 2048 * 2;
constexpr size_t W_MKB = W_Z + (size_t)TPAD * INW * 2;
constexpr size_t W_VTB = W_MKB + (size_t)1024 * 1024 * 2;
constexpr size_t W_YCAT = W_VTB + (size_t)1024 * 1024 * 2;
constexpr size_t W_XR = W_YCAT + (size_t)3 * TPAD * 1024 * 2;
constexpr size_t W_SA = W_XR + (size_t)TPAD * 1024 * 2;
constexpr size_t W_SU = W_SA + (size_t)TPAD * 1024 * 4;
constexpr size_t W_CHK = W_SU + (size_t)TPAD * 1024 * 4;
constexpr size_t W_MF = W_CHK + (size_t)2 * 4 * 32 * 1024 * 4;
constexpr size_t W_MB = W_MF + (size_t)TPAD * DM * 4;
constexpr size_t W_SCU = W_MB + (size_t)TPAD * DM * 2;
constexpr size_t W_SCV = W_SCU + 16384 * 4;
constexpr size_t W_BAR = W_SCV + 16384 * 4;
constexpr size_t W_END = W_BAR + 2048;
constexpr size_t W_H1 = W_Z;
constexpr size_t W_X1F = W_Z + (size_t)TPAD * DM * 4;
constexpr size_t W_X1B = W_X1F + (size_t)TPAD * DM * 4;
constexpr size_t W_QP = W_YCAT;
constexpr size_t W_SC = W_MF;
constexpr size_t W_PICKS = W_SA;
static_assert(W_X1B + (size_t)TPAD * DM * 2 <= W_MKB, "alias overflow");
static_assert((size_t)TPAD * DM * 2 <= (size_t)3 * TPAD * 1024 * 2, "alias overflow");

struct Params {
    const float* in[31];
    float* out;
    unsigned char* ws;
    int ph_lo, ph_hi;
};

typedef __bf16 bf16x2_t __attribute__((ext_vector_type(2)));
__device__ __forceinline__ unsigned cvt_pk_bf16(float lo, float hi) { const f32x2 v = {lo, hi}; return __builtin_bit_cast(unsigned, __builtin_convertvector(v, bf16x2_t)); }
__device__ __forceinline__ float bf_lo(unsigned w) { return __uint_as_float(w << 16); }
__device__ __forceinline__ float bf_hi(unsigned w) { return __uint_as_float(w & 0xffff0000u); }
__device__ __forceinline__ float bf1(bf16_t b) { return __uint_as_float(((unsigned)b) << 16); }
__device__ __forceinline__ bf16_t f2bf(float f) { return (bf16_t)(cvt_pk_bf16(f, 0.f) & 0xffffu); }
__device__ __forceinline__ void unpack8(u32x4 w, float* v) {
    v[0] = bf_lo(w.x); v[1] = bf_hi(w.x); v[2] = bf_lo(w.y); v[3] = bf_hi(w.y); v[4] = bf_lo(w.z); v[5] = bf_hi(w.z); v[6] = bf_lo(w.w); v[7] = bf_hi(w.w);
}
__device__ __forceinline__ u32x4 pack8(const float* v) {
    u32x4 w; w.x = cvt_pk_bf16(v[0], v[1]); w.y = cvt_pk_bf16(v[2], v[3]); w.z = cvt_pk_bf16(v[4], v[5]); w.w = cvt_pk_bf16(v[6], v[7]); return w;
}
__device__ __forceinline__ float fast_exp(float x) { return __builtin_amdgcn_exp2f(x * 1.4426950408889634f); }
__device__ __forceinline__ float sigmoidf_(float x) { return __builtin_amdgcn_rcpf(1.0f + fast_exp(-x)); }
__device__ __forceinline__ float gelu_tanh(float x) {
    const float z = 0.7978845608028654f * (x + 0.044715f * x * x * x);
    const float th = 1.0f - 2.0f * __builtin_amdgcn_rcpf(1.0f + fast_exp(2.0f * z));
    return 0.5f * x * (1.0f + th);
}
__device__ __forceinline__ int launder_tid() { int t = threadIdx.x; asm volatile("" : "+v"(t)); return t; }
__device__ __forceinline__ float wave_sum(float v) {
#pragma unroll
    for (int o = 32; o > 0; o >>= 1) v += __shfl_xor(v, o, 64);
    return v;
}

constexpr int BM = 256, BK = 64, HALF = 128, HTB = HALF * BK * 2, STAGE_BYTES = 8 * HTB, NXCD = 8, WGM = 4;
__device__ __forceinline__ int lds_byte(int r, int c) { const int st = (r >> 4) * 2 + (c >> 5), rr = r & 15, cc = c & 31, ob = rr * 64 + cc * 2; return st * 1024 + (ob ^ (((ob >> 9) & 1) << 5)); }
__device__ __forceinline__ void stage_rc(int b, int& R, int& C) { const int st = b / 1024, sb = b % 1024, swz = sb ^ (((sb >> 9) & 1) << 5); R = (st >> 1) * 16 + swz / 64; C = (st & 1) * 32 + (swz % 64) / 2; }
__device__ __forceinline__ int perm32(int rho) { const int n = rho >> 4, i = rho & 15; return 8 * (i >> 2) + 4 * n + (i & 3); }

struct Unit { int pm, pn, ka; };
struct Gemm { const bf16_t* A; const bf16_t* Bt; int lda, ldb, K; };

__device__ __forceinline__ void std_tile(int L, int nM, int nN, int& pm, int& pn) {
    const int nwg = nM * nN; int wgid = L;
    { const int q = nwg / NXCD, r = nwg % NXCD, xcd = wgid % NXCD, off = wgid / NXCD; wgid = (xcd < r ? xcd * (q + 1) : r * (q + 1) + (xcd - r) * q) + off; }
    const int nig = WGM * nN, gid = wgid / nig, fm = gid * WGM, gsz = (nM - fm) < WGM ? (nM - fm) : WGM;
    pm = fm + ((wgid % nig) % gsz); pn = (wgid % nig) / gsz;
}

template <class Epi, class Sched>
__device__ __forceinline__ void gemm_phase(LAS unsigned char* lds, const Gemm g, const Sched& S, const Epi& E) {
    const int tid = threadIdx.x, wid = __builtin_amdgcn_readfirstlane(tid >> 6), lane = tid & 63, wr = wid >> 2, wc = wid & 3, fr = lane & 15, fq = lane >> 4;
    const int K = g.K, nt = K / BK;
    unsigned voffA[2], voffB[2];
#pragma unroll
    for (int i = 0; i < 2; ++i) { int R, C; stage_rc(tid * 16 + i * 8192, R, C); const int Rb = Epi::PERM ? ((R & ~31) + perm32(R & 31)) : R;
        voffA[i] = (unsigned)(R * g.lda + C) * 2u; voffB[i] = (unsigned)(Rb * g.ldb + C) * 2u; }
    const size_t kstep = (size_t)(BK * 2);
    const size_t hstepA = (size_t)HALF * g.lda * 2, hstepB = (size_t)HALF * g.ldb * 2;
    const size_t tstepA = 2 * hstepA, tstepB = 2 * hstepB;
    const unsigned ldsw = (unsigned)wid * 1024u;
    const int aoff = lds_byte(wr * 64 + fr, fq * 8), boff = lds_byte(wc * 32 + fr, fq * 8);
#define PG8_SA(b, h) (((b) * 2 + (h)) * HTB)
#define PG8_SB(b, h) ((4 + (b) * 2 + (h)) * HTB)
#define PG8_STAGE(bufoff, gbase, voff) do { _Pragma("unroll") for (int _i = 0; _i < 2; ++_i) \
        __builtin_amdgcn_global_load_lds((const unsigned*)((const char*)(gbase) + (voff)[_i]), (LAS unsigned*)(lds + (bufoff) + ldsw + _i * 8192), 16, 0, 0); } while (0)
#define PG8_LDA(dst, b, h) do { _Pragma("unroll") for (int m = 0; m < 4; ++m) _Pragma("unroll") for (int k = 0; k < 2; ++k) dst[m][k] = *(const LAS bf16x8*)(lds + PG8_SA(b, h) + aoff + m * 2048 + k * 1024); } while (0)
#define PG8_LDB(dst, b, h) do { _Pragma("unroll") for (int n = 0; n < 2; ++n) _Pragma("unroll") for (int k = 0; k < 2; ++k) dst[n][k] = *(const LAS bf16x8*)(lds + PG8_SB(b, h) + boff + n * 2048 + k * 1024); } while (0)
#define PG8_MMA(ai, bj, At, Bt) do { __builtin_amdgcn_s_setprio(1); _Pragma("unroll") for (int m = 0; m < 4; ++m) _Pragma("unroll") for (int n = 0; n < 2; ++n) _Pragma("unroll") for (int k = 0; k < 2; ++k) \
        acc[ai][bj][m][n] = __builtin_amdgcn_mfma_f32_16x16x32_bf16(Bt[n][k], At[m][k], acc[ai][bj][m][n], 0, 0, 0); __builtin_amdgcn_s_setprio(0); } while (0)
#define PG8_WAIT_V(n) asm volatile("s_waitcnt vmcnt(" #n ")" ::: "memory")
#define PG8_WAIT_L(n) asm volatile("s_waitcnt lgkmcnt(" #n ")" ::: "memory")
#define PG8_BAR __builtin_amdgcn_s_barrier()
#define PG8_SCHED __builtin_amdgcn_sched_barrier(0)
    Unit cur, nxt; int ui = 0;
    if (!S.next(0, cur)) return;
    f32x4 acc[2][2][4][2];
#pragma unroll
    for (int a = 0; a < 2; ++a)
#pragma unroll
        for (int b = 0; b < 2; ++b)
#pragma unroll
            for (int m = 0; m < 4; ++m)
#pragma unroll
                for (int n = 0; n < 2; ++n) acc[a][b][m][n] = (f32x4){0.f, 0.f, 0.f, 0.f};
    bf16x8 At[4][2], B0[2][2], B1[2][2];
    const char* cA = (const char*)g.A + (size_t)cur.pm * tstepA + (size_t)cur.ka * 2; const char* cB = (const char*)g.Bt + (size_t)cur.pn * tstepB;
    PG8_STAGE(PG8_SB(0, 0), cB, voffB); PG8_STAGE(PG8_SA(0, 0), cA, voffA); PG8_STAGE(PG8_SB(0, 1), cB + hstepB, voffB); PG8_STAGE(PG8_SA(0, 1), cA + hstepA, voffA);
    if (wr == 1) PG8_BAR;
    PG8_WAIT_V(4); PG8_BAR;
    PG8_STAGE(PG8_SB(1, 0), cB + kstep, voffB); PG8_STAGE(PG8_SA(1, 0), cA + kstep, voffA); PG8_STAGE(PG8_SB(1, 1), cB + hstepB + kstep, voffB);
    PG8_WAIT_V(6); PG8_BAR;
    for (;;) {
        const bool has_next = S.next(ui + 1, nxt);
        const char* nA = has_next ? (const char*)g.A + (size_t)nxt.pm * tstepA + (size_t)nxt.ka * 2 : cA; const char* nB = has_next ? (const char*)g.Bt + (size_t)nxt.pn * tstepB : cB;
        for (int t = 0; t < nt; t += 2) {
            const bool last = (t == nt - 2);
            const char* a1 = cA + (size_t)(t + 1) * kstep;
            const char* a2 = last ? nA : cA + (size_t)(t + 2) * kstep; const char* b2 = last ? nB : cB + (size_t)(t + 2) * kstep;
            const char* a3 = a2 + kstep; const char* b3 = b2 + kstep;
            PG8_LDB(B0, 0, 0); PG8_SCHED; PG8_LDA(At, 0, 0); PG8_STAGE(PG8_SA(1, 1), a1 + hstepA, voffA);
            PG8_WAIT_L(8); PG8_BAR; PG8_WAIT_L(0); PG8_MMA(0, 0, At, B0); PG8_BAR; PG8_SCHED;
            PG8_LDB(B1, 0, 1); PG8_STAGE(PG8_SB(0, 0), b2, voffB);
            PG8_BAR; PG8_WAIT_L(0); PG8_MMA(0, 1, At, B1); PG8_BAR;
            PG8_LDA(At, 0, 1); PG8_STAGE(PG8_SA(0, 0), a2, voffA);
            PG8_BAR; PG8_WAIT_L(0); PG8_MMA(1, 0, At, B0); PG8_BAR; PG8_SCHED;
            PG8_STAGE(PG8_SB(0, 1), b2 + hstepB, voffB);
            PG8_WAIT_V(6); PG8_BAR; PG8_MMA(1, 1, At, B1); PG8_BAR;
            PG8_LDB(B0, 1, 0); PG8_SCHED; PG8_LDA(At, 1, 0); PG8_STAGE(PG8_SA(0, 1), a2 + hstepA, voffA);
            PG8_WAIT_L(8); PG8_BAR; PG8_WAIT_L(0); PG8_MMA(0, 0, At, B0); PG8_BAR; PG8_SCHED;
            PG8_LDB(B1, 1, 1); PG8_STAGE(PG8_SB(1, 0), b3, voffB);
            PG8_BAR; PG8_WAIT_L(0); PG8_MMA(0, 1, At, B1); PG8_BAR;
            PG8_LDA(At, 1, 1); PG8_STAGE(PG8_SA(1, 0), a3, voffA);
            PG8_BAR; PG8_WAIT_L(0); PG8_MMA(1, 0, At, B0); PG8_BAR; PG8_SCHED;
            PG8_STAGE(PG8_SB(1, 1), b3 + hstepB, voffB);
            PG8_WAIT_V(6); PG8_BAR; PG8_MMA(1, 1, At, B1); PG8_BAR;
        }
        E(acc, cur, wr, wc, fr, fq);
        if (!has_next) break;
#pragma unroll
        for (int a = 0; a < 2; ++a)
#pragma unroll
            for (int b = 0; b < 2; ++b)
#pragma unroll
                for (int m = 0; m < 4; ++m)
#pragma unroll
                    for (int n = 0; n < 2; ++n) acc[a][b][m][n] = (f32x4){0.f, 0.f, 0.f, 0.f};
        cur = nxt; cA = nA; cB = nB; ++ui;
    }
    PG8_WAIT_V(0);
    if (wr == 0) PG8_BAR;
    PG8_BAR;
#undef PG8_SA
#undef PG8_SB
#undef PG8_STAGE
#undef PG8_LDA
#undef PG8_LDB
#undef PG8_MMA
#undef PG8_WAIT_V
#undef PG8_WAIT_L
#undef PG8_BAR
#undef PG8_SCHED
}

struct SchedGrid {
    int nM, nN, G, c, kaMode;
    __device__ bool next(int i, Unit& u) const {
        const int L = i * G + c; if (L >= nM * nN) return false;
        std_tile(L, nM, nN, u.pm, u.pn);
        u.ka = kaMode == 0 ? 0 : (kaMode == 1 ? (u.pn & ~1) * 128 : u.pn * 256);
        return true;
    }
};
struct Sched1 {
    int G, c;
    __device__ bool next(int i, Unit& u) const {
        const int L = i * G + c; u.ka = 0;
        if (L < 32 * 48) { std_tile(L, 32, 48, u.pm, u.pn); return true; }
        const int j = L - 32 * 48; if (j >= 32) return false;
        u.pm = 33 + (j >> 3); u.pn = 48 + (j & 7); return true;
    }
};
struct SchedMKV {
    int G, c;
    __device__ bool next(int i, Unit& u) const { const int L = i * G + c; if (L >= 32) return false; u.pm = 33 + (L >> 3); u.pn = 48 + (L & 7); u.ka = 0; return true; }
};
struct Sched5 {
    int G, c;
    __device__ bool next(int i, Unit& u) const {
        const int T = (i / 3) * G + c, j = i % 3; if (T >= 32 * 8) return false;
        int pm, pn; std_tile(T, 32, 8, pm, pn);
        u.pm = j * 33 + pm; u.pn = j * 8 + pn; u.ka = 0; return true;
    }
};

struct Epi1 {
    static constexpr bool PERM = true;
    bf16_t* Z; float* omk; float* omv; bf16_t* MKB; bf16_t* VTB;
    __device__ __forceinline__ void operator()(const f32x4 (&acc)[2][2][4][2], const Unit& u, int wr, int wc, int fr, int fq) const {
        if (u.pn < 48) {
            const int row0 = u.pm * BM + wr * 64 + fr, col0 = u.pn * BM + wc * 32 + 8 * fq;
#pragma unroll
            for (int ai = 0; ai < 2; ++ai)
#pragma unroll
                for (int m = 0; m < 4; ++m) { bf16_t* rowp = Z + (size_t)(row0 + ai * HALF + m * 16) * INW + col0;
#pragma unroll
                    for (int bj = 0; bj < 2; ++bj) { const f32x4 v0 = acc[ai][bj][m][0], v1 = acc[ai][bj][m][1];
                        u32x4 w; w.x = cvt_pk_bf16(v0[0], v0[1]); w.y = cvt_pk_bf16(v0[2], v0[3]); w.z = cvt_pk_bf16(v1[0], v1[1]); w.w = cvt_pk_bf16(v1[2], v1[3]);
                        *(u32x4*)(rowp + bj * HALF) = w; } }
        } else {
            const int row0 = (u.pm - 33) * BM + wr * 64 + fr, col0 = (u.pn - 48) * BM + wc * 32 + 8 * fq;
            const bool isv = (u.pn - 48) >= 4;
#pragma unroll
            for (int ai = 0; ai < 2; ++ai)
#pragma unroll
                for (int m = 0; m < 4; ++m) { const int row = row0 + ai * HALF + m * 16;
#pragma unroll
                    for (int bj = 0; bj < 2; ++bj) { const f32x4 v0 = acc[ai][bj][m][0], v1 = acc[ai][bj][m][1]; const int col = col0 + bj * HALF;
                        if (!isv) {
                            float* o = omk + (size_t)row * 1024 + col; *(f32x4*)o = v0; *(f32x4*)(o + 4) = v1;
                            u32x4 w; w.x = cvt_pk_bf16(v0[0], v0[1]); w.y = cvt_pk_bf16(v0[2], v0[3]); w.z = cvt_pk_bf16(v1[0], v1[1]); w.w = cvt_pk_bf16(v1[2], v1[3]);
                            *(u32x4*)(MKB + (size_t)row * 1024 + col) = w;
                        } else {
                            const int cm = col - 1024; float* o = omv + (size_t)row * 1024 + cm; *(f32x4*)o = v0; *(f32x4*)(o + 4) = v1;
                            bf16_t* vt = VTB + ((size_t)(row >> 8) * 1024 + cm) * 256 + (row & 255);
#pragma unroll
                            for (int e = 0; e < 4; ++e) { vt[(size_t)e * 256] = f2bf(v0[e]); vt[(size_t)(e + 4) * 256] = f2bf(v1[e]); }
                        } } }
        }
    }
};
struct Epi3 {
    static constexpr bool PERM = false;
    const bf16_t* __restrict__ XR; float* __restrict__ SA; float* __restrict__ SU; const float* ba; const float* bx; const float* lam;
    __device__ __forceinline__ void operator()(const f32x4 (&acc)[2][2][4][2], const Unit& u, int wr, int wc, int fr, int fq) const {
        const int row0 = u.pm * BM + wr * 64 + fr, ch0 = u.pn * 128 + wc * 32 + 4 * fq;
        u32x2 xw[2][2][4];
#pragma unroll
        for (int n = 0; n < 2; ++n)
#pragma unroll
            for (int ai = 0; ai < 2; ++ai)
#pragma unroll
                for (int m = 0; m < 4; ++m) xw[n][ai][m] = *(const u32x2*)(XR + (size_t)(row0 + ai * HALF + m * 16) * 1024 + ch0 + n * 16);
#pragma unroll
        for (int n = 0; n < 2; ++n) {
            const int ch = ch0 + n * 16;
            const f32x4 vba = *(const f32x4*)(ba + ch), vbx = *(const f32x4*)(bx + ch), l = *(const f32x4*)(lam + ch); f32x4 vsp;
#pragma unroll
            for (int j = 0; j < 4; ++j) { const float ex = fast_exp(-l[j]);
                const float sp = ex < 0.03f ? ex * (1.0f + ex * (-0.5f + ex * (0.33333333f - 0.25f * ex))) : __logf(1.0f + ex); vsp[j] = -8.0f * sp; }
#pragma unroll
            for (int ai = 0; ai < 2; ++ai)
#pragma unroll
                for (int m = 0; m < 4; ++m) { const int row = row0 + ai * HALF + m * 16; if (row >= TT) continue;
                    const u32x2 xv = xw[n][ai][m];
                    const float xr[4] = {bf_lo(xv.x), bf_hi(xv.x), bf_lo(xv.y), bf_hi(xv.y)}; f32x4 av, uv;
#pragma unroll
                    for (int j = 0; j < 4; ++j) { const float r = sigmoidf_(acc[ai][0][m][n][j] + vba[j]), ig = sigmoidf_(acc[ai][1][m][n][j] + vbx[j]);
                        const float la = vsp[j] * r; av[j] = fast_exp(la); uv[j] = __builtin_amdgcn_sqrtf(fmaxf(1.0f - av[j] * av[j], 0.f)) * ig * xr[j]; }
                    *(f32x4*)(SA + (size_t)row * 1024 + ch) = av; *(f32x4*)(SU + (size_t)row * 1024 + ch) = uv; }
        }
    }
};
struct Epi5 {
    static constexpr bool PERM = true;
    const bf16_t* __restrict__ Z; bf16_t* __restrict__ P0; bf16_t* __restrict__ P1; bf16_t* __restrict__ MB;
    __device__ __forceinline__ void operator()(const f32x4 (&acc)[2][2][4][2], const Unit& u, int wr, int wc, int fr, int fq) const {
        const int j = u.pn >> 3, pm = u.pm - j * 33, pn = u.pn & 7;
        const int row0 = pm * BM + wr * 64 + fr, col0 = pn * BM + wc * 32 + 8 * fq;
        const bf16_t* __restrict__ src = (j == 1) ? P0 : P1; bf16_t* __restrict__ dst = (j == 0) ? P0 : (j == 1 ? P1 : MB);
#pragma unroll
        for (int ai = 0; ai < 2; ++ai) {
            u32x4 gw[4][2], pw[4][2];
#pragma unroll
            for (int m = 0; m < 4; ++m)
#pragma unroll
                for (int bj = 0; bj < 2; ++bj) { const int row = row0 + ai * HALF + m * 16, col = col0 + bj * HALF;
                    gw[m][bj] = *(const u32x4*)(Z + (size_t)row * INW + 6144 + j * 2048 + col);
                    pw[m][bj] = (j > 0) ? *(const u32x4*)(src + (size_t)row * DM + col) : (u32x4){0u, 0u, 0u, 0u}; }
#pragma unroll
            for (int m = 0; m < 4; ++m)
#pragma unroll
                for (int bj = 0; bj < 2; ++bj) { const int row = row0 + ai * HALF + m * 16, col = col0 + bj * HALF;
                    float gv[8], pv[8], r[8]; unpack8(gw[m][bj], gv); unpack8(pw[m][bj], pv);
#pragma unroll
                    for (int e = 0; e < 4; ++e) { r[e] = sigmoidf_(gv[e]) * acc[ai][bj][m][0][e] + pv[e]; r[e + 4] = sigmoidf_(gv[e + 4]) * acc[ai][bj][m][1][e] + pv[e + 4]; }
                    *(u32x4*)(dst + (size_t)row * DM + col) = pack8(r); }
        }
    }
};
struct Epi6 {
    static constexpr bool PERM = false;
    const float* xp; const float* xs; float* H1;
    __device__ __forceinline__ void operator()(const f32x4 (&acc)[2][2][4][2], const Unit& u, int wr, int wc, int fr, int fq) const {
        const int row0 = u.pm * BM + wr * 64 + fr, col0 = u.pn * BM + wc * 32 + 4 * fq;
#pragma unroll
        for (int ai = 0; ai < 2; ++ai)
#pragma unroll
            for (int m = 0; m < 4; ++m) { const int row = row0 + ai * HALF + m * 16; if (row >= TT) continue;
                const float* xrow = row < TP ? xp + (size_t)row * DM : xs + (size_t)(row - TP) * DM;
#pragma unroll
                for (int bj = 0; bj < 2; ++bj)
#pragma unroll
                    for (int n = 0; n < 2; ++n) { const int col = col0 + bj * HALF + n * 16; const f32x4 xv = *(const f32x4*)(xrow + col);
                        *(f32x4*)(H1 + (size_t)row * DM + col) = xv * DN_ALPHA + acc[ai][bj][m][n]; } }
    }
};
struct EpiB {
    static constexpr bool PERM = true;
    bf16_t* O; int ldc;
    __device__ __forceinline__ void operator()(const f32x4 (&acc)[2][2][4][2], const Unit& u, int wr, int wc, int fr, int fq) const {
        const int row0 = u.pm * BM + wr * 64 + fr, col0 = u.pn * BM + wc * 32 + 8 * fq;
#pragma unroll
        for (int ai = 0; ai < 2; ++ai)
#pragma unroll
            for (int m = 0; m < 4; ++m) { bf16_t* rowp = O + (size_t)(row0 + ai * HALF + m * 16) * ldc + col0;
#pragma unroll
                for (int bj = 0; bj < 2; ++bj) { const f32x4 v0 = acc[ai][bj][m][0], v1 = acc[ai][bj][m][1];
                    u32x4 w; w.x = cvt_pk_bf16(v0[0], v0[1]); w.y = cvt_pk_bf16(v0[2], v0[3]); w.z = cvt_pk_bf16(v1[0], v1[1]); w.w = cvt_pk_bf16(v1[2], v1[3]);
                    *(u32x4*)(rowp + bj * HALF) = w; } }
    }
};
struct EpiF {
    static constexpr bool PERM = false;
    float* C; int ldc;
    __device__ __forceinline__ void operator()(const f32x4 (&acc)[2][2][4][2], const Unit& u, int wr, int wc, int fr, int fq) const {
        const int row0 = u.pm * BM + wr * 64 + fr, col0 = u.pn * BM + wc * 32 + 4 * fq;
#pragma unroll
        for (int ai = 0; ai < 2; ++ai)
#pragma unroll
            for (int m = 0; m < 4; ++m) { float* rowp = C + (size_t)(row0 + ai * HALF + m * 16) * ldc + col0;
#pragma unroll
                for (int bj = 0; bj < 2; ++bj)
#pragma unroll
                    for (int n = 0; n < 2; ++n) *(f32x4*)(rowp + bj * HALF + n * 16) = acc[ai][bj][m][n]; }
    }
};

__device__ void cvt_flat(const float* __restrict__ src, bf16_t* __restrict__ dst, size_t n, size_t gtid, size_t gth) {
    for (size_t i = gtid * 8; i < n; i += gth * 8) {
        const f32x4 a = *(const f32x4*)(src + i), b = *(const f32x4*)(src + i + 4);
        u32x4 w; w.x = cvt_pk_bf16(a[0], a[1]); w.y = cvt_pk_bf16(a[2], a[3]); w.z = cvt_pk_bf16(b[0], b[1]); w.w = cvt_pk_bf16(b[2], b[3]);
        *(u32x4*)(dst + i) = w;
    }
}
__device__ void transpose_cvt(float* lds, const float* __restrict__ src, bf16_t* __restrict__ dst, int K, int N, int bid, int nb) {
    const int tn = N / 64, ntile = (K / 64) * tn;
    for (int t = bid; t < ntile; t += nb) {
        const int k0 = (t / tn) * 64, n0 = (t % tn) * 64;
#pragma unroll
        for (int i = 0; i < 2; ++i) { const int idx = threadIdx.x + i * 512, r = idx >> 4, c4 = (idx & 15) * 4;
            const f32x4 v = *(const f32x4*)(src + (size_t)(k0 + r) * N + n0 + c4);
            lds[r * 65 + c4] = v[0]; lds[r * 65 + c4 + 1] = v[1]; lds[r * 65 + c4 + 2] = v[2]; lds[r * 65 + c4 + 3] = v[3]; }
        __syncthreads();
        { const int n = threadIdx.x >> 3, kc = (threadIdx.x & 7) * 8; float v[8];
#pragma unroll
            for (int i = 0; i < 8; ++i) v[i] = lds[(kc + i) * 65 + n];
            *(u32x4*)(dst + (size_t)(n0 + n) * K + k0 + kc) = pack8(v); }
        __syncthreads();
    }
}


__device__ void cvt_fp8_rows(const float* __restrict__ src, unsigned char* __restrict__ dst, float* __restrict__ inv, int nrows, int gw, int nw) {
    const int lane = threadIdx.x & 63;
    for (int row = gw; row < nrows; row += nw) {
        f32x4 v[2][4]; float mx = 0.f;
#pragma unroll
        for (int j = 0; j < 2; ++j)
#pragma unroll
            for (int q = 0; q < 4; ++q) { v[j][q] = *(const f32x4*)(src + (size_t)row * 2048 + j * 1024 + lane * 16 + q * 4);
                mx = fmaxf(mx, fmaxf(fmaxf(fabsf(v[j][q][0]), fabsf(v[j][q][1])), fmaxf(fabsf(v[j][q][2]), fabsf(v[j][q][3])))); }
#pragma unroll
        for (int o = 32; o > 0; o >>= 1) mx = fmaxf(mx, __shfl_xor(mx, o, 64));
        int k = 8 - ((int)((__float_as_uint(mx) >> 23) & 0xffu) - 126); k = k > 100 ? 100 : (k < -100 ? -100 : k);
        if (mx == 0.f) k = 0;
        const float sc = __uint_as_float((unsigned)(127 + k) << 23), isc = __uint_as_float((unsigned)(127 - k) << 23);
#pragma unroll
        for (int j = 0; j < 2; ++j) { u32x4 w;
#pragma unroll
            for (int q = 0; q < 4; ++q) { int t = 0; t = __builtin_amdgcn_cvt_pk_fp8_f32(v[j][q][0] * sc, v[j][q][1] * sc, t, false); t = __builtin_amdgcn_cvt_pk_fp8_f32(v[j][q][2] * sc, v[j][q][3] * sc, t, true); w[q] = (unsigned)t; }
            *(u32x4*)(dst + (size_t)row * 2048 + j * 1024 + lane * 16) = w; }
        if (lane == 0) inv[row] = isc;
    }
}

__device__ void phase0(const Params& p, float* lds) {
    const int bid = blockIdx.x, nb = gridDim.x; const size_t gtid = (size_t)bid * 512 + threadIdx.x, gth = (size_t)nb * 512;
    unsigned char* ws = p.ws;
    bf16_t* AALL = (bf16_t*)(ws + W_AALL); bf16_t* BTALL = (bf16_t*)(ws + W_BTALL);
    transpose_cvt(lds, p.in[8], BTALL, 2048, 12288, bid, nb);
    transpose_cvt(lds, p.in[17], BTALL + (size_t)12288 * 2048, 2048, 1024, bid, nb);
    transpose_cvt(lds, p.in[18], BTALL + (size_t)13312 * 2048, 2048, 1024, bid, nb);
    transpose_cvt(lds, p.in[19], (bf16_t*)(ws + W_WBRT), 1024, 2048, bid, nb);
    transpose_cvt(lds, p.in[20], (bf16_t*)(ws + W_WBRT) + (size_t)2048 * 1024, 1024, 2048, bid, nb);
    transpose_cvt(lds, p.in[21], (bf16_t*)(ws + W_WBRT) + (size_t)2 * 2048 * 1024, 1024, 2048, bid, nb);
    transpose_cvt(lds, p.in[22], (bf16_t*)(ws + W_WOT), 2048, 2048, bid, nb);
    transpose_cvt(lds, p.in[25], (bf16_t*)(ws + W_WQT), 2048, 2048, bid, nb);
    cvt_flat(p.in[0], AALL, (size_t)TP * DM, gtid, gth);
    cvt_flat(p.in[1], AALL + (size_t)TP * DM, (size_t)TS * DM, gtid, gth);
    cvt_flat(p.in[2], AALL + (size_t)TPAD * DM, (size_t)NMEM * DM, gtid, gth);
    bf16_t* WGT = (bf16_t*)(ws + W_WGT); bf16_t* WKT = (bf16_t*)(ws + W_WKT);
    for (size_t idx = gtid; idx < (size_t)2048 * 256; idx += gth) {
        const int k = (int)(idx & 255), ng = (int)(idx >> 8), h = ng >> 8, n = ng & 255;
        float v = 0.f;
        if ((k >> 7) == (h & 1)) { const float* w = (n < 128) ? p.in[12] : p.in[14]; v = w[((size_t)h * 128 + (k & 127)) * 128 + (n & 127)]; }
        WGT[idx] = f2bf(v);
        float v2 = 0.f; const int c = n >> 7;
        if ((k >> 7) == c) v2 = p.in[26][(((size_t)h * 2 + c) * 128 + (n & 127)) * 128 + (k & 127)];
        WKT[idx] = f2bf(v2);
    }
}

__device__ __forceinline__ u32x4 ldz(const bf16_t* Z, int t, int col) { return *(const u32x4*)(Z + (size_t)t * INW + col); }

__device__ void p2_elem_prompt(const Params& p, int item) {
    const int TIDX = launder_tid();
    const bf16_t* __restrict__ Z = (const bf16_t*)(p.ws + W_Z); bf16_t* __restrict__ Y0 = (bf16_t*)(p.ws + W_YCAT); bf16_t* __restrict__ XR = (bf16_t*)(p.ws + W_XR);
    const int run = item * 4 + (TIDX >> 7), c0 = (TIDX & 127) * 8, t0 = run * 16, b = t0 >> 11, s0 = t0 & 2047;
    float cw[3][8], rw[4][8], rb[8];
#pragma unroll
    for (int k = 0; k < 3; ++k) { const f32x4 a = *(const f32x4*)(p.in[9] + k * 1024 + c0), bb = *(const f32x4*)(p.in[9] + k * 1024 + c0 + 4);
#pragma unroll
        for (int e = 0; e < 4; ++e) { cw[k][e] = a[e]; cw[k][e + 4] = bb[e]; } }
#pragma unroll
    for (int k = 0; k < 4; ++k) { const f32x4 a = *(const f32x4*)(p.in[10] + k * 1024 + c0), bb = *(const f32x4*)(p.in[10] + k * 1024 + c0 + 4);
#pragma unroll
        for (int e = 0; e < 4; ++e) { rw[k][e] = a[e]; rw[k][e + 4] = bb[e]; } }
    { const f32x4 a = *(const f32x4*)(p.in[11] + c0), bb = *(const f32x4*)(p.in[11] + c0 + 4);
#pragma unroll
        for (int e = 0; e < 4; ++e) { rb[e] = a[e]; rb[e + 4] = bb[e]; } }
    float z2[8], z1[8], r3[8], r2[8], r1[8];
#pragma unroll
    for (int e = 0; e < 8; ++e) { z2[e] = z1[e] = r3[e] = r2[e] = r1[e] = 0.f; }
    if (s0 > 0) {
        float a[8], bb[8];
        unpack8(ldz(Z, t0 - 2, 1024 + c0), a); unpack8(ldz(Z, t0 - 2, 2048 + c0), bb);
#pragma unroll
        for (int e = 0; e < 8; ++e) z2[e] = a[e] * bb[e];
        unpack8(ldz(Z, t0 - 1, 1024 + c0), a); unpack8(ldz(Z, t0 - 1, 2048 + c0), bb);
#pragma unroll
        for (int e = 0; e < 8; ++e) z1[e] = a[e] * bb[e];
        unpack8(ldz(Z, t0 - 3, 3072 + c0), r3); unpack8(ldz(Z, t0 - 2, 3072 + c0), r2); unpack8(ldz(Z, t0 - 1, 3072 + c0), r1);
    }
#pragma unroll 1
    for (int sb = 0; sb < 16; sb += 4) {
        u32x4 wcb[4], wcc[4], wcx[4], wrx[4];
#pragma unroll
        for (int s = 0; s < 4; ++s) { const int t = t0 + sb + s; wcb[s] = ldz(Z, t, c0); wcc[s] = ldz(Z, t, 1024 + c0); wcx[s] = ldz(Z, t, 2048 + c0); wrx[s] = ldz(Z, t, 3072 + c0); }
#pragma unroll
        for (int s = 0; s < 4; ++s) {
            const int t = t0 + sb + s, sq = s0 + sb + s;
            float cb[8], cc[8], cx[8], rx[8], zc[8], yc[8], xr[8];
            unpack8(wcb[s], cb); unpack8(wcc[s], cc); unpack8(wcx[s], cx); unpack8(wrx[s], rx);
#pragma unroll
            for (int e = 0; e < 8; ++e) { zc[e] = cc[e] * cx[e]; yc[e] = cb[e] * (cw[0][e] * z2[e] + cw[1][e] * z1[e] + cw[2][e] * zc[e]);
                xr[e] = rw[0][e] * r3[e] + rw[1][e] * r2[e] + rw[2][e] * r1[e] + rw[3][e] * rx[e] + rb[e]; }
            *(u32x4*)(Y0 + (size_t)t * 1024 + c0) = pack8(yc);
            *(u32x4*)(XR + (size_t)t * 1024 + c0) = pack8(xr);
            if (sq >= 2046) { float* o = p.out + O_CZP + ((size_t)b * 2 + (sq - 2046)) * 1024 + c0; *(f32x4*)o = (f32x4){zc[0], zc[1], zc[2], zc[3]}; *(f32x4*)(o + 4) = (f32x4){zc[4], zc[5], zc[6], zc[7]}; }
            if (sq >= 2045) { float* o = p.out + O_RCP + ((size_t)b * 3 + (sq - 2045)) * 1024 + c0; *(f32x4*)o = (f32x4){rx[0], rx[1], rx[2], rx[3]}; *(f32x4*)(o + 4) = (f32x4){rx[4], rx[5], rx[6], rx[7]}; }
#pragma unroll
            for (int e = 0; e < 8; ++e) { z2[e] = z1[e]; z1[e] = zc[e]; r3[e] = r2[e]; r2[e] = r1[e]; r1[e] = rx[e]; }
        }
    }
}
__device__ __forceinline__ void ld8f(const float* p, float* v) { const f32x4 a = *(const f32x4*)p, b = *(const f32x4*)(p + 4);
#pragma unroll
    for (int e = 0; e < 4; ++e) { v[e] = a[e]; v[e + 4] = b[e]; } }
__device__ __forceinline__ void st8f(float* p, const float* v) { *(f32x4*)p = (f32x4){v[0], v[1], v[2], v[3]}; *(f32x4*)(p + 4) = (f32x4){v[4], v[5], v[6], v[7]}; }

__device__ void p2_elem_sample(const Params& p, int item) {
    const int TIDX = launder_tid();
    const bf16_t* Z = (const bf16_t*)(p.ws + W_Z); bf16_t* Y0 = (bf16_t*)(p.ws + W_YCAT); bf16_t* XR = (bf16_t*)(p.ws + W_XR);
    const int bs = item * 4 + (TIDX >> 7), c0 = (TIDX & 127) * 8, t = TP + bs;
    float cw[3][8], rw[4][8], rb[8], z2[8], z1[8], r3[8], r2[8], r1[8];
#pragma unroll
    for (int k = 0; k < 3; ++k) ld8f(p.in[9] + k * 1024 + c0, cw[k]);
#pragma unroll
    for (int k = 0; k < 4; ++k) ld8f(p.in[10] + k * 1024 + c0, rw[k]);
    ld8f(p.in[11] + c0, rb);
    ld8f(p.in[5] + ((size_t)bs * 2 + 0) * 1024 + c0, z2); ld8f(p.in[5] + ((size_t)bs * 2 + 1) * 1024 + c0, z1);
    ld8f(p.in[6] + ((size_t)bs * 3 + 0) * 1024 + c0, r3); ld8f(p.in[6] + ((size_t)bs * 3 + 1) * 1024 + c0, r2); ld8f(p.in[6] + ((size_t)bs * 3 + 2) * 1024 + c0, r1);
    float cb[8], cc[8], cx[8], rx[8], zc[8], yc[8], xr[8];
    unpack8(ldz(Z, t, c0), cb); unpack8(ldz(Z, t, 1024 + c0), cc); unpack8(ldz(Z, t, 2048 + c0), cx); unpack8(ldz(Z, t, 3072 + c0), rx);
#pragma unroll
    for (int e = 0; e < 8; ++e) { zc[e] = cc[e] * cx[e]; yc[e] = cb[e] * (cw[0][e] * z2[e] + cw[1][e] * z1[e] + cw[2][e] * zc[e]);
        xr[e] = rw[0][e] * r3[e] + rw[1][e] * r2[e] + rw[2][e] * r1[e] + rw[3][e] * rx[e] + rb[e]; }
    *(u32x4*)(Y0 + (size_t)t * 1024 + c0) = pack8(yc);
    *(u32x4*)(XR + (size_t)t * 1024 + c0) = pack8(xr);
    st8f(p.out + O_CZS + ((size_t)bs * 2 + 0) * 1024 + c0, z1); st8f(p.out + O_CZS + ((size_t)bs * 2 + 1) * 1024 + c0, zc);
    st8f(p.out + O_RCS + ((size_t)bs * 3 + 0) * 1024 + c0, r2); st8f(p.out + O_RCS + ((size_t)bs * 3 + 1) * 1024 + c0, r1); st8f(p.out + O_RCS + ((size_t)bs * 3 + 2) * 1024 + c0, rx);
}

__device__ void p2_attn_prompt(const Params& p, int item) {
    const bf16_t* Z = (const bf16_t*)(p.ws + W_Z); const bf16_t* MKB = (const bf16_t*)(p.ws + W_MKB); const bf16_t* VTB = (const bf16_t*)(p.ws + W_VTB);
    bf16_t* Y2 = (bf16_t*)(p.ws + W_YCAT) + (size_t)2 * TPAD * 1024;
    const int b = item >> 6, h = (item >> 4) & 3, qt = item & 15;
    const int w = threadIdx.x >> 6, lane = threadIdx.x & 63, fr = lane & 15, fq = lane >> 4;
    const int t = b * 2048 + qt * 128 + w * 16 + fr;
    bf16x8 qf[8];
#pragma unroll
    for (int ks = 0; ks < 8; ++ks) qf[ks] = *(const bf16x8*)(Z + (size_t)t * INW + 5120 + h * 256 + ks * 32 + fq * 8);
    f32x4 sacc[16];
#pragma unroll
    for (int nb = 0; nb < 16; ++nb) {
        sacc[nb] = (f32x4){0.f, 0.f, 0.f, 0.f};
        const bf16_t* kp = MKB + (size_t)(b * 256 + nb * 16 + fr) * 1024 + h * 256 + fq * 8;
#pragma unroll
        for (int ks = 0; ks < 8; ++ks) { const bf16x8 kf = *(const bf16x8*)(kp + ks * 32); sacc[nb] = __builtin_amdgcn_mfma_f32_16x16x32_bf16(kf, qf[ks], sacc[nb], 0, 0, 0); }
    }
    float mx = -3.0e38f;
#pragma unroll
    for (int nb = 0; nb < 16; ++nb)
#pragma unroll
        for (int j = 0; j < 4; ++j) { sacc[nb][j] *= 0.0625f; mx = fmaxf(mx, sacc[nb][j]); }
    mx = fmaxf(mx, __shfl_xor(mx, 16, 64)); mx = fmaxf(mx, __shfl_xor(mx, 32, 64));
    float sum = 0.f;
#pragma unroll
    for (int nb = 0; nb < 16; ++nb)
#pragma unroll
        for (int j = 0; j < 4; ++j) { sacc[nb][j] = fast_exp(sacc[nb][j] - mx); sum += sacc[nb][j]; }
    sum += __shfl_xor(sum, 16, 64); sum += __shfl_xor(sum, 32, 64);
    const float inv = 1.0f / sum;
    bf16x8 pf[8];
#pragma unroll
    for (int s2 = 0; s2 < 8; ++s2) {
        u32x4 w4; w4.x = cvt_pk_bf16(sacc[2 * s2][0] * inv, sacc[2 * s2][1] * inv); w4.y = cvt_pk_bf16(sacc[2 * s2][2] * inv, sacc[2 * s2][3] * inv);
        w4.z = cvt_pk_bf16(sacc[2 * s2 + 1][0] * inv, sacc[2 * s2 + 1][1] * inv); w4.w = cvt_pk_bf16(sacc[2 * s2 + 1][2] * inv, sacc[2 * s2 + 1][3] * inv);
        pf[s2] = __builtin_bit_cast(bf16x8, w4);
    }
#pragma unroll 4
    for (int db = 0; db < 16; ++db) {
        f32x4 o = (f32x4){0.f, 0.f, 0.f, 0.f};
        const bf16_t* vp = VTB + ((size_t)b * 1024 + h * 256 + db * 16 + fr) * 256 + fq * 4;
#pragma unroll
        for (int s2 = 0; s2 < 8; ++s2) { const u32x2 v0 = *(const u32x2*)(vp + s2 * 32), v1 = *(const u32x2*)(vp + s2 * 32 + 16);
            u32x4 vv; vv.x = v0.x; vv.y = v0.y; vv.z = v1.x; vv.w = v1.y;
            o = __builtin_amdgcn_mfma_f32_16x16x32_bf16(__builtin_bit_cast(bf16x8, vv), pf[s2], o, 0, 0, 0); }
        u32x2 ow; ow.x = cvt_pk_bf16(o[0], o[1]); ow.y = cvt_pk_bf16(o[2], o[3]);
        *(u32x2*)(Y2 + (size_t)t * 1024 + h * 256 + db * 16 + fq * 4) = ow;
    }
}

__device__ void p2_attn_sample(const Params& p, int pair, float* lds) {
    const int TIDX = launder_tid();
    const bf16_t* Z = (const bf16_t*)(p.ws + W_Z); bf16_t* Y2 = (bf16_t*)(p.ws + W_YCAT) + (size_t)2 * TPAD * 1024;
    const int w = TIDX >> 6, lane = TIDX & 63, kq = lane >> 4, dl = lane & 15;
    const int b = pair >> 2, h = pair & 3;
    f32x4 qv[4];
#pragma unroll
    for (int j = 0; j < 4; ++j) { const u32x2 qw = *(const u32x2*)(Z + (size_t)(TP + b) * INW + 5120 + h * 256 + dl * 4 + 64 * j);
        qv[j] = (f32x4){bf_lo(qw.x), bf_hi(qw.x), bf_lo(qw.y), bf_hi(qw.y)} * 0.0625f; }
    const float* Kc = p.in[3]; const float* Vc = p.in[4];
    float sc[8];
#pragma unroll
    for (int i = 0; i < 8; ++i) {
        const int key = w * 32 + 4 * i + kq; const float* kp = Kc + (((size_t)b * 256 + key) * 4 + h) * 256 + dl * 4;
        float d = 0.f;
#pragma unroll
        for (int j = 0; j < 4; ++j) { const f32x4 kv = *(const f32x4*)(kp + 64 * j); d += kv[0] * qv[j][0] + kv[1] * qv[j][1] + kv[2] * qv[j][2] + kv[3] * qv[j][3]; }
        d += __shfl_xor(d, 1, 64); d += __shfl_xor(d, 2, 64); d += __shfl_xor(d, 4, 64); d += __shfl_xor(d, 8, 64);
        sc[i] = d;
    }
    float mx = sc[0];
#pragma unroll
    for (int i = 1; i < 8; ++i) mx = fmaxf(mx, sc[i]);
    mx = fmaxf(mx, __shfl_xor(mx, 16, 64)); mx = fmaxf(mx, __shfl_xor(mx, 32, 64));
    float l = 0.f; f32x4 o[4];
#pragma unroll
    for (int j = 0; j < 4; ++j) o[j] = (f32x4){0.f, 0.f, 0.f, 0.f};
#pragma unroll
    for (int i = 0; i < 8; ++i) {
        const float pe = fast_exp(sc[i] - mx); l += pe;
        const int key = w * 32 + 4 * i + kq; const float* vp = Vc + (((size_t)b * 256 + key) * 4 + h) * 256 + dl * 4;
#pragma unroll
        for (int j = 0; j < 4; ++j) { const f32x4 vv = *(const f32x4*)(vp + 64 * j); o[j] += vv * pe; }
    }
    l += __shfl_xor(l, 16, 64); l += __shfl_xor(l, 32, 64);
#pragma unroll
    for (int j = 0; j < 4; ++j)
#pragma unroll
        for (int e = 0; e < 4; ++e) { float v = o[j][e]; v += __shfl_xor(v, 16, 64); v += __shfl_xor(v, 32, 64); o[j][e] = v; }
    float* my = lds + w * 260;
    if (kq == 0) {
#pragma unroll
        for (int j = 0; j < 4; ++j) *(f32x4*)(my + dl * 4 + 64 * j) = o[j];
        if (dl == 0) { my[256] = mx; my[257] = l; }
    }
    __syncthreads();
    if (TIDX < 256) {
        const int d = TIDX; float M = lds[256];
#pragma unroll
        for (int ww = 1; ww < 8; ++ww) M = fmaxf(M, lds[ww * 260 + 256]);
        float L = 0.f, v = 0.f;
#pragma unroll
        for (int ww = 0; ww < 8; ++ww) { const float e = fast_exp(lds[ww * 260 + 256] - M); L += e * lds[ww * 260 + 257]; v += e * lds[ww * 260 + d]; }
        Y2[(size_t)(TP + b) * 1024 + h * 256 + d] = f2bf(v / L);
    }
    __syncthreads();
}

template <int NB>
__device__ __forceinline__ void skinny_acc(f32x4 (&acc)[NB], const bf16_t* __restrict__ Arow, const bf16_t* __restrict__ Brow, size_t nbstride, int K) {
    bf16x8 a0[4], b0[NB][4], a1[4], b1[NB][4];
#define SK_LOAD(a, b, kk) do { _Pragma("unroll") for (int s2 = 0; s2 < 4; ++s2) { a[s2] = *(const bf16x8*)(Arow + (kk) + s2 * 32); \
        _Pragma("unroll") for (int nb = 0; nb < NB; ++nb) b[nb][s2] = *(const bf16x8*)(Brow + nb * nbstride + (kk) + s2 * 32); } } while (0)
#define SK_MMA(a, b) do { _Pragma("unroll") for (int s2 = 0; s2 < 4; ++s2) _Pragma("unroll") for (int nb = 0; nb < NB; ++nb) acc[nb] = __builtin_amdgcn_mfma_f32_16x16x32_bf16(b[nb][s2], a[s2], acc[nb], 0, 0, 0); } while (0)
    SK_LOAD(a0, b0, 0);
#pragma unroll 1
    for (int k0 = 0; k0 < K; k0 += 256) {
        SK_LOAD(a1, b1, k0 + 128);
        SK_MMA(a0, b0);
        if (k0 + 256 < K) SK_LOAD(a0, b0, k0 + 256);
        SK_MMA(a1, b1);
    }
#undef SK_LOAD
#undef SK_MMA
}

template <int NB, int KB>
__device__ __forceinline__ void skinny_k(f32x4 (&acc)[NB][8], const bf16_t* __restrict__ A0, int lda, const bf16_t* __restrict__ B0, size_t nbstride, int ksteps) {
#pragma unroll 1
    for (int ks = 0; ks < ksteps; ks += KB) {
        bf16x8 a[KB][8], b[KB][NB];
#pragma unroll
        for (int s2 = 0; s2 < KB; ++s2) {
#pragma unroll
            for (int rb = 0; rb < 8; ++rb) a[s2][rb] = *(const bf16x8*)(A0 + (size_t)rb * 16 * lda + (ks + s2) * 32);
#pragma unroll
            for (int nb = 0; nb < NB; ++nb) b[s2][nb] = *(const bf16x8*)(B0 + nb * nbstride + (ks + s2) * 32); }
#pragma unroll
        for (int s2 = 0; s2 < KB; ++s2)
#pragma unroll
            for (int nb = 0; nb < NB; ++nb)
#pragma unroll
                for (int rb = 0; rb < 8; ++rb) acc[nb][rb] = __builtin_amdgcn_mfma_f32_16x16x32_bf16(b[s2][nb], a[s2][rb], acc[nb][rb], 0, 0, 0);
    }
}
__device__ __forceinline__ f32x4 xwave_reduce(float* lds, const f32x4 (&acc)[8], int w, int lane) {
    __syncthreads();
#pragma unroll
    for (int rb = 0; rb < 8; ++rb) *(f32x4*)(lds + ((w * 8 + rb) * 64 + lane) * 4) = acc[rb];
    __syncthreads();
    f32x4 v = *(const f32x4*)(lds + ((0 * 8 + w) * 64 + lane) * 4);
#pragma unroll
    for (int w2 = 1; w2 < 8; ++w2) v += *(const f32x4*)(lds + ((w2 * 8 + w) * 64 + lane) * 4);
    return v;
}
__device__ void s1_zin(const Params& p, int ti, float* lds) {
    const int w = threadIdx.x >> 6, lane = threadIdx.x & 63, fr = lane & 15, fq = lane >> 4, n0 = ti * 48, kw0 = w * 256;
    const bf16_t* A0 = (const bf16_t*)(p.ws + W_AALL) + (size_t)(TP + fr) * DM + fq * 8 + kw0; const bf16_t* B0 = (const bf16_t*)(p.ws + W_BTALL) + (size_t)(n0 + fr) * DM + fq * 8 + kw0;
    f32x4 acc[3][8];
#pragma unroll
    for (int nb = 0; nb < 3; ++nb)
#pragma unroll
        for (int rb = 0; rb < 8; ++rb) acc[nb][rb] = (f32x4){0.f, 0.f, 0.f, 0.f};
    skinny_k<3, 2>(acc, A0, DM, B0, (size_t)16 * DM, 8);
    bf16_t* Z = (bf16_t*)(p.ws + W_Z); const int row = TP + 16 * w + fr;
#pragma unroll
    for (int nb = 0; nb < 3; ++nb) { const f32x4 v = xwave_reduce(lds, acc[nb], w, lane);
        u32x2 o; o.x = cvt_pk_bf16(v[0], v[1]); o.y = cvt_pk_bf16(v[2], v[3]); *(u32x2*)(Z + (size_t)row * INW + n0 + nb * 16 + 4 * fq) = o; }
}
__device__ void s3_gates(const Params& p, int ti) {
    const int w = threadIdx.x >> 6, lane = threadIdx.x & 63, fr = lane & 15, fq = lane >> 4, row = TP + 16 * w + fr, h = ti >> 3, nb = ti & 7;
    const bf16_t* XR = (const bf16_t*)(p.ws + W_XR);
    const bf16_t* A = XR + (size_t)row * 1024 + (h & ~1) * 128 + fq * 8; const bf16_t* B = (const bf16_t*)(p.ws + W_WGT) + (size_t)(h * 256 + nb * 16 + fr) * 256 + fq * 8;
    f32x4 acc[2] = {{0.f, 0.f, 0.f, 0.f}, {0.f, 0.f, 0.f, 0.f}};
    skinny_acc<2>(acc, A, B, (size_t)128 * 256, 256);
    const int ch = h * 128 + nb * 16 + 4 * fq;
    const f32x4 vba = *(const f32x4*)(p.in[13] + ch), vbx = *(const f32x4*)(p.in[15] + ch), l = *(const f32x4*)(p.in[16] + ch);
    const u32x2 xw = *(const u32x2*)(XR + (size_t)row * 1024 + ch); const float xr[4] = {bf_lo(xw.x), bf_hi(xw.x), bf_lo(xw.y), bf_hi(xw.y)}; f32x4 av, uv;
#pragma unroll
    for (int j = 0; j < 4; ++j) { const float ex = fast_exp(-l[j]); const float sp = ex < 0.03f ? ex * (1.0f + ex * (-0.5f + ex * (0.33333333f - 0.25f * ex))) : __logf(1.0f + ex);
        const float r = sigmoidf_(acc[0][j] + vba[j]), ig = sigmoidf_(acc[1][j] + vbx[j]); const float la = -8.0f * sp * r;
        av[j] = fast_exp(la); uv[j] = __builtin_amdgcn_sqrtf(fmaxf(1.0f - av[j] * av[j], 0.f)) * ig * xr[j]; }
    *(f32x4*)((float*)(p.ws + W_SA) + (size_t)row * 1024 + ch) = av; *(f32x4*)((float*)(p.ws + W_SU) + (size_t)row * 1024 + ch) = uv;
}
__device__ void s5_merge(const Params& p, int ti, float* lds) {
    const int w = threadIdx.x >> 6, lane = threadIdx.x & 63, fr = lane & 15, fq = lane >> 4, n0 = ti * 16, col = n0 + 4 * fq, kw0 = w * 128;
    const bf16_t* Z = (const bf16_t*)(p.ws + W_Z);
    f32x4 m[8];
#pragma unroll
    for (int rb = 0; rb < 8; ++rb) m[rb] = (f32x4){0.f, 0.f, 0.f, 0.f};
#pragma unroll 1
    for (int j = 0; j < 3; ++j) {
        const bf16_t* A0 = (const bf16_t*)(p.ws + W_YCAT) + ((size_t)j * TPAD + TP + fr) * 1024 + fq * 8 + kw0; const bf16_t* B0 = (const bf16_t*)(p.ws + W_WBRT) + ((size_t)j * 2048 + n0 + fr) * 1024 + fq * 8 + kw0;
        f32x4 acc[1][8];
#pragma unroll
        for (int rb = 0; rb < 8; ++rb) acc[0][rb] = (f32x4){0.f, 0.f, 0.f, 0.f};
        u32x2 gw[8];
#pragma unroll
        for (int rb = 0; rb < 8; ++rb) gw[rb] = *(const u32x2*)(Z + (size_t)(TP + rb * 16 + fr) * INW + 6144 + j * 2048 + col);
        skinny_k<1, 4>(acc, A0, 1024, B0, 0, 4);
#pragma unroll
        for (int rb = 0; rb < 8; ++rb) { m[rb][0] += sigmoidf_(bf_lo(gw[rb].x)) * acc[0][rb][0]; m[rb][1] += sigmoidf_(bf_hi(gw[rb].x)) * acc[0][rb][1];
            m[rb][2] += sigmoidf_(bf_lo(gw[rb].y)) * acc[0][rb][2]; m[rb][3] += sigmoidf_(bf_hi(gw[rb].y)) * acc[0][rb][3]; }
    }
    const f32x4 v = xwave_reduce(lds, m, w, lane);
    u32x2 o; o.x = cvt_pk_bf16(v[0], v[1]); o.y = cvt_pk_bf16(v[2], v[3]); *(u32x2*)((bf16_t*)(p.ws + W_MB) + (size_t)(TP + 16 * w + fr) * DM + col) = o;
}
__device__ void s68_plain(const Params& p, int ti, size_t wA, size_t wB, float* outF, bf16_t* outB, float* lds) {
    const int w = threadIdx.x >> 6, lane = threadIdx.x & 63, fr = lane & 15, fq = lane >> 4, n0 = ti * 16, col = n0 + 4 * fq, kw0 = w * 256;
    const bf16_t* A0 = (const bf16_t*)(p.ws + wA) + (size_t)(TP + fr) * DM + fq * 8 + kw0; const bf16_t* B0 = (const bf16_t*)(p.ws + wB) + (size_t)(n0 + fr) * DM + fq * 8 + kw0;
    f32x4 acc[1][8];
#pragma unroll
    for (int rb = 0; rb < 8; ++rb) acc[0][rb] = (f32x4){0.f, 0.f, 0.f, 0.f};
    skinny_k<1, 4>(acc, A0, DM, B0, 0, 8);
    const f32x4 v = xwave_reduce(lds, acc[0], w, lane); const int row = TP + 16 * w + fr;
    if (outF) *(f32x4*)(outF + (size_t)row * DM + col) = v;
    else { u32x2 o; o.x = cvt_pk_bf16(v[0], v[1]); o.y = cvt_pk_bf16(v[2], v[3]); *(u32x2*)(outB + (size_t)row * DM + col) = o; }
}
__device__ void s9_scores(const Params& p, int ti) {
    const int w = threadIdx.x >> 6, lane = threadIdx.x & 63, fr = lane & 15, fq = lane >> 4, row = TP + 16 * w + fr, h = ti >> 3, nbp = ti & 7;
    const bf16_t* A = (const bf16_t*)(p.ws + W_QP) + (size_t)row * DM + h * 256 + fq * 8; const bf16_t* B = (const bf16_t*)(p.ws + W_WKT) + (size_t)(h * 256 + nbp * 32 + fr) * 256 + fq * 8;
    f32x4 acc[2] = {{0.f, 0.f, 0.f, 0.f}, {0.f, 0.f, 0.f, 0.f}};
    skinny_acc<2>(acc, A, B, (size_t)16 * 256, 256);
    float* SC = (float*)(p.ws + W_SC) + (size_t)row * DM + h * 256 + nbp * 32 + 4 * fq;
    *(f32x4*)SC = acc[0]; *(f32x4*)(SC + 16) = acc[1];
}

__device__ void p4a(const Params& p) {
    const float* SA = (const float*)(p.ws + W_SA); const float* SU = (const float*)(p.ws + W_SU); float* CA = (float*)(p.ws + W_CHK); float* CH = CA + 4 * 32 * 1024;
    for (int idx = blockIdx.x * 512 + threadIdx.x; idx < 4 * 32 * 1024; idx += gridDim.x * 512) {
        const int ch = idx & 1023, chunk = (idx >> 10) & 31, b = idx >> 15; const size_t base = ((size_t)b * 2048 + chunk * 64) * 1024 + ch;
        float A = 1.f, H = 0.f;
#pragma unroll 8
        for (int s = 0; s < 64; ++s) { const float a = SA[base + (size_t)s * 1024], u = SU[base + (size_t)s * 1024]; H = a * H + u; A *= a; }
        CA[idx] = A; CH[idx] = H;
    }
}
__device__ void p4b(const Params& p) {
    const float* __restrict__ SA = (const float*)(p.ws + W_SA); const float* __restrict__ SU = (const float*)(p.ws + W_SU); const float* __restrict__ CA = (const float*)(p.ws + W_CHK); const float* __restrict__ CH = CA + 4 * 32 * 1024;
    const bf16_t* __restrict__ Z = (const bf16_t*)(p.ws + W_Z); bf16_t* __restrict__ Y1 = (bf16_t*)(p.ws + W_YCAT) + (size_t)TPAD * 1024;
    const int nprompt = 4 * 32 * 1024, ntot = nprompt + TS * 1024;
    for (int idx = blockIdx.x * 512 + threadIdx.x; idx < ntot; idx += gridDim.x * 512) {
        if (idx < nprompt) {
            const int ch = idx & 1023, chunk = (idx >> 10) & 31, b = idx >> 15;
            float h = 0.f;
#pragma unroll 1
            for (int j0 = 0; j0 < chunk; j0 += 8) {
                float ca[8], chh[8];
#pragma unroll
                for (int e = 0; e < 8; ++e) { const int jj = min(j0 + e, 31), q = ((b * 32 + jj) << 10) + ch; ca[e] = CA[q]; chh[e] = CH[q]; }
#pragma unroll
                for (int e = 0; e < 8; ++e) if (j0 + e < chunk) h = ca[e] * h + chh[e];
            }
            const size_t t0 = (size_t)b * 2048 + chunk * 64;
#pragma unroll 1
            for (int s0 = 0; s0 < 64; s0 += 16) {
                float a[16], u[16], rg[16];
#pragma unroll
                for (int s = 0; s < 16; ++s) { const size_t t = t0 + s0 + s; a[s] = SA[t * 1024 + ch]; u[s] = SU[t * 1024 + ch]; rg[s] = bf1(Z[t * INW + 4096 + ch]); }
#pragma unroll
                for (int s = 0; s < 16; ++s) { h = a[s] * h + u[s]; Y1[(t0 + s0 + s) * 1024 + ch] = f2bf(h * gelu_tanh(rg[s])); }
            }
            if (chunk == 31) p.out[O_HP + (size_t)b * 1024 + ch] = h;
        } else {
            const int j = idx - nprompt, ch = j & 1023, bs = j >> 10; const size_t t = TP + bs;
            const float h = SA[t * 1024 + ch] * p.in[7][(size_t)bs * 1024 + ch] + SU[t * 1024 + ch];
            p.out[O_HS + (size_t)bs * 1024 + ch] = h;
            const float rg = bf1(Z[t * INW + 4096 + ch]); Y1[t * 1024 + ch] = f2bf(h * gelu_tanh(rg));
        }
    }
}


__device__ void p4a_tile(const Params& p, int pm, int h) {
    const float* SA = (const float*)(p.ws + W_SA); const float* SU = (const float*)(p.ws + W_SU); float* CA = (float*)(p.ws + W_CHK); float* CH = CA + 4 * 32 * 1024;
    const int ch = h * 128 + (threadIdx.x & 127), row0 = pm * 256 + (threadIdx.x >> 7) * 64, b = row0 >> 11, chunk = (row0 & 2047) >> 6;
    const size_t base = (size_t)row0 * 1024 + ch;
    float A = 1.f, H = 0.f;
#pragma unroll 1
    for (int s0 = 0; s0 < 64; s0 += 16) { float a[16], u[16];
#pragma unroll
        for (int s2 = 0; s2 < 16; ++s2) { a[s2] = SA[base + (size_t)(s0 + s2) * 1024]; u[s2] = SU[base + (size_t)(s0 + s2) * 1024]; }
#pragma unroll
        for (int s2 = 0; s2 < 16; ++s2) { H = a[s2] * H + u[s2]; A *= a[s2]; } }
    const int idx = ((b * 32 + chunk) << 10) + ch; CA[idx] = A; CH[idx] = H;
}
__device__ void s9_full(const Params& p, int h) {
    const int w = threadIdx.x >> 6, lane = threadIdx.x & 63, fr = lane & 15, fq = lane >> 4, row = TP + 16 * w + fr;
    const bf16_t* A = (const bf16_t*)(p.ws + W_QP) + (size_t)row * DM + h * 256 + fq * 8; float* SC = (float*)(p.ws + W_SC) + (size_t)row * DM + h * 256 + 4 * fq;
#pragma unroll 1
    for (int g4 = 0; g4 < 4; ++g4) {
        const bf16_t* B = (const bf16_t*)(p.ws + W_WKT) + (size_t)(h * 256 + g4 * 64 + fr) * 256 + fq * 8;
        f32x4 acc[4] = {{0.f, 0.f, 0.f, 0.f}, {0.f, 0.f, 0.f, 0.f}, {0.f, 0.f, 0.f, 0.f}, {0.f, 0.f, 0.f, 0.f}};
        skinny_acc<4>(acc, A, B, (size_t)16 * 256, 256);
#pragma unroll
        for (int nb = 0; nb < 4; ++nb) *(f32x4*)(SC + g4 * 64 + nb * 16) = acc[nb];
    }
}

__device__ void p7(const Params& p, float* lds) {
    const float* H1 = (const float*)(p.ws + W_H1); bf16_t* X1B = (bf16_t*)(p.ws + W_X1B);
    const int lane = threadIdx.x & 63, w = threadIdx.x >> 6, gw = blockIdx.x * 8 + w, nw = gridDim.x * 8;
    for (int row = gw; row < TP; row += nw) {
        f32x4 v[8]; float s = 0.f; const float* xrow = p.in[0] + (size_t)row * DM;
#pragma unroll
        for (int j = 0; j < 8; ++j) { v[j] = *(const f32x4*)(H1 + (size_t)row * DM + j * 256 + lane * 4) + *(const f32x4*)(xrow + j * 256 + lane * 4) * DN_ALPHA; s += v[j][0] + v[j][1] + v[j][2] + v[j][3]; }
        const float mean = wave_sum(s) * (1.0f / DM); float q = 0.f;
#pragma unroll
        for (int j = 0; j < 8; ++j) { v[j] -= mean; q += v[j][0] * v[j][0] + v[j][1] * v[j][1] + v[j][2] * v[j][2] + v[j][3] * v[j][3]; }
        const float rstd = rsqrtf(wave_sum(q) * (1.0f / DM) + LN_EPS);
#pragma unroll
        for (int j = 0; j < 8; ++j) { const int c = j * 256 + lane * 4; const f32x4 g = *(const f32x4*)(p.in[23] + c), bb = *(const f32x4*)(p.in[24] + c);
            const f32x4 y = v[j] * rstd * g + bb;
            u32x2 wd; wd.x = cvt_pk_bf16(y[0], y[1]); wd.y = cvt_pk_bf16(y[2], y[3]); *(u32x2*)(X1B + (size_t)row * DM + c) = wd; }
    }
    for (int r = blockIdx.x; r < TS; r += gridDim.x) {
        const int row = TP + r, c = w * 256 + lane * 4;
        f32x4 v = *(const f32x4*)(H1 + (size_t)row * DM + c) + *(const f32x4*)(p.in[1] + (size_t)r * DM + c) * DN_ALPHA;
        const float s = wave_sum(v[0] + v[1] + v[2] + v[3]);
        __syncthreads();
        if (lane == 0) lds[w] = s;
        __syncthreads();
        float tot = 0.f;
#pragma unroll
        for (int ww = 0; ww < 8; ++ww) tot += lds[ww];
        v -= tot * (1.0f / DM);
        const float q = wave_sum(v[0] * v[0] + v[1] * v[1] + v[2] * v[2] + v[3] * v[3]);
        if (lane == 0) lds[8 + w] = q;
        __syncthreads();
        float qt = 0.f;
#pragma unroll
        for (int ww = 0; ww < 8; ++ww) qt += lds[8 + ww];
        const float rstd = rsqrtf(qt * (1.0f / DM) + LN_EPS);
        const f32x4 g = *(const f32x4*)(p.in[23] + c), bb = *(const f32x4*)(p.in[24] + c); const f32x4 y = v * rstd * g + bb;
        u32x2 wd; wd.x = cvt_pk_bf16(y[0], y[1]); wd.y = cvt_pk_bf16(y[2], y[3]); *(u32x2*)(X1B + (size_t)row * DM + c) = wd;
    }
}

__device__ __forceinline__ unsigned ord_key(float f) { const unsigned u = __float_as_uint(f); return (u & 0x80000000u) ? ~u : (u | 0x80000000u); }
__device__ __forceinline__ float ord_val(unsigned k) { return __uint_as_float((k & 0x80000000u) ? (k & 0x7fffffffu) : ~k); }

#define CE_DESC(a, b) do { const unsigned mx_ = max(a, b), mn_ = min(a, b); a = mx_; b = mn_; } while (0)
__device__ void p9b(const Params& p, int mode) {
    const float* SC = (const float*)(p.ws + W_SC); u32x4* PICKS = (u32x4*)(p.ws + W_PICKS); const float* SCU = (const float*)(p.ws + W_SCU); const float* SCV = (const float*)(p.ws + W_SCV);
    const int nitem = TT * 16, gid = blockIdx.x * 512 + threadIdx.x, gth = gridDim.x * 512;
    int pm1 = 0, h1 = 0; if (mode == 1) std_tile((int)blockIdx.x, 32, 8, pm1, h1);
    const bool fast = (mode == 0 && gth == TP * 16);
    const int npass = (mode == 1 || fast) ? 2 : (nitem + gth - 1) / gth;
#pragma unroll 1
    for (int pass_ = 0; pass_ < npass; ++pass_) {
        int item = gid + pass_ * gth;
        if (mode == 1) { const int tt = pass_ == 0 ? pm1 * 256 + (int)(threadIdx.x >> 1) : TP + (int)(threadIdx.x >> 1), hh = pass_ == 0 ? h1 : (int)blockIdx.x;
            item = (pass_ == 0 || (blockIdx.x < 8 && threadIdx.x < 256)) ? ((tt * 8 + hh) << 1) + (int)(threadIdx.x & 1) : nitem; }
        if (fast && pass_ == 1) item = (threadIdx.x < 64 && blockIdx.x < 32) ? TP * 16 + (int)blockIdx.x * 64 + (int)threadIdx.x : nitem;
        if (item >= nitem) continue;
        const int c = item & 1, th = item >> 1, t = th >> 3, h = th & 7;
        const float* sp = SC + (size_t)t * DM + h * 256 + c * 128;
        unsigned key[128];
#pragma unroll
        for (int i = 0; i < 32; ++i) { const f32x4 v = *(const f32x4*)(sp + i * 4);
#pragma unroll
            for (int e = 0; e < 4; ++e) key[i * 4 + e] = (ord_key(v[e]) & 0xffffff80u) | (unsigned)(127 - (i * 4 + e)); }
#pragma unroll
        for (int gq = 0; gq < 8; ++gq)
#pragma unroll
            for (int k = 2; k <= 16; k <<= 1)
#pragma unroll
                for (int j = k >> 1; j > 0; j >>= 1)
#pragma unroll
                    for (int i = 0; i < 16; ++i) { const int l = i ^ j; if (l > i) { if ((i & k) == 0) CE_DESC(key[gq * 16 + i], key[gq * 16 + l]); else CE_DESC(key[gq * 16 + l], key[gq * 16 + i]); } }
#pragma unroll
        for (int span = 1; span < 8; span <<= 1)
#pragma unroll
            for (int gq = 0; gq < 8; gq += 2 * span) {
#pragma unroll
                for (int i = 0; i < 16; ++i) key[gq * 16 + i] = max(key[gq * 16 + i], key[(gq + span) * 16 + 15 - i]);
#pragma unroll
                for (int j = 8; j > 0; j >>= 1)
#pragma unroll
                    for (int i = 0; i < 16; ++i) { const int l = i ^ j; if (l > i) CE_DESC(key[gq * 16 + i], key[gq * 16 + l]); }
            }
        unsigned top[16];
#pragma unroll
        for (int q = 0; q < 16; ++q) top[q] = key[q];
        float sm[16], so[16]; int im[16], io[16];
#pragma unroll
        for (int q = 0; q < 16; ++q) { sm[q] = ord_val(top[q] & 0xffffff80u); im[q] = 127 - (int)(top[q] & 127u); so[q] = __shfl_xor(sm[q], 1, 64); io[q] = __shfl_xor(im[q], 1, 64); }
        float s1[16], s2[16]; int i1[16], i2[16];
#pragma unroll
        for (int q = 0; q < 16; ++q) { s1[q] = c ? so[q] : sm[q]; s2[q] = c ? sm[q] : so[q]; i1[q] = c ? io[q] : im[q]; i2[q] = c ? im[q] : io[q]; }
        unsigned ck[50]; int nc = 0;
#pragma unroll
        for (int i = 0; i < 16; ++i)
#pragma unroll
            for (int j = 0; j < 16; ++j) if ((i + 1) * (j + 1) <= 16) { ck[nc] = (ord_key(s1[i] + s2[j]) & 0xffffff00u) | (unsigned)(255 - (i * 16 + j)); ++nc; }
        unsigned c64[64];
#pragma unroll
        for (int i = 0; i < 64; ++i) c64[i] = (i < 50) ? ck[i] : 0u;
#pragma unroll
        for (int gq = 0; gq < 4; ++gq)
#pragma unroll
            for (int k = 2; k <= 16; k <<= 1)
#pragma unroll
                for (int j = k >> 1; j > 0; j >>= 1)
#pragma unroll
                    for (int i = 0; i < 16; ++i) { const int l = i ^ j; if (l > i) { if ((i & k) == 0) CE_DESC(c64[gq * 16 + i], c64[gq * 16 + l]); else CE_DESC(c64[gq * 16 + l], c64[gq * 16 + i]); } }
#pragma unroll
        for (int span = 1; span < 4; span <<= 1)
#pragma unroll
            for (int gq = 0; gq < 4; gq += 2 * span) {
#pragma unroll
                for (int i = 0; i < 16; ++i) c64[gq * 16 + i] = max(c64[gq * 16 + i], c64[(gq + span) * 16 + 15 - i]);
#pragma unroll
                for (int j = 8; j > 0; j >>= 1)
#pragma unroll
                    for (int i = 0; i < 16; ++i) { const int l = i ^ j; if (l > i) CE_DESC(c64[gq * 16 + i], c64[gq * 16 + l]); }
            }
        unsigned ct[16];
#pragma unroll
        for (int q = 0; q < 16; ++q) ct[q] = c64[q];
        const float vmax = ord_val(ct[0] & 0xffffff00u); float ev[16], esum = 0.f;
#pragma unroll
        for (int q = 0; q < 16; ++q) { ev[q] = fast_exp(ord_val(ct[q] & 0xffffff00u) - vmax); esum += ev[q]; }
        const float einv = 1.0f / esum;
#pragma unroll
        for (int q = 0; q < 8; ++q) {
            const unsigned cm = (unsigned)(-c);
            const unsigned kk = ct[2 * q] ^ ((ct[2 * q] ^ ct[2 * q + 1]) & cm);
            const unsigned eb0 = __float_as_uint(ev[2 * q]), eb1 = __float_as_uint(ev[2 * q + 1]);
            const float gwt = __uint_as_float(eb0 ^ ((eb0 ^ eb1) & cm)) * einv;
            const int cid = 255 - (int)(kk & 255u), ci = cid >> 4, cj = cid & 15;
            int e1 = 0, e2 = 0;
#pragma unroll
            for (int r = 0; r < 16; ++r) { e1 = (ci == r) ? i1[r] : e1; e2 = (cj == r) ? i2[r] : e2; }
            const int ex = e1 * 128 + e2;
            u32x4 pk; pk.x = (unsigned)ex; pk.y = __float_as_uint(gwt * SCV[ex]); pk.z = __float_as_uint(SCU[ex]); pk.w = 0u;
            PICKS[(size_t)t * 128 + h * 16 + 2 * q + c] = pk;
        }
    }
}

__device__ void p10(const Params& p, float* lds) {
    const bf16_t* X1B = (const bf16_t*)(p.ws + W_X1B); const u32x4* PICKS = (const u32x4*)(p.ws + W_PICKS);
    const unsigned char* U8 = p.ws + W_UB; const unsigned char* V8 = p.ws + W_VB;
    const int w = threadIdx.x >> 6, lane = threadIdx.x & 63;
    for (int t = blockIdx.x; t < TT; t += gridDim.x) {
        f32x2 xe[2][8];
#pragma unroll
        for (int j = 0; j < 2; ++j)
#pragma unroll
            for (int q = 0; q < 2; ++q) { const u32x4 v = *(const u32x4*)(X1B + (size_t)t * DM + j * 1024 + lane * 16 + q * 8);
                xe[j][4 * q] = (f32x2){bf_lo(v.x), bf_hi(v.x)}; xe[j][4 * q + 1] = (f32x2){bf_lo(v.y), bf_hi(v.y)}; xe[j][4 * q + 2] = (f32x2){bf_lo(v.z), bf_hi(v.z)}; xe[j][4 * q + 3] = (f32x2){bf_lo(v.w), bf_hi(v.w)}; }
        const u32x4 mypick = PICKS[(size_t)t * 128 + w * 16 + (lane & 15)];
        f32x2 y[2][8];
#pragma unroll
        for (int j = 0; j < 2; ++j)
#pragma unroll
            for (int e = 0; e < 8; ++e) y[j][e] = (f32x2){0.f, 0.f};
#pragma unroll 1
        for (int k = 0; k < 16; k += 8) {
            u32x4 uw[8][2], vw[8][2]; float cvv[8], suu[8];
#pragma unroll
            for (int g = 0; g < 8; ++g) {
                const unsigned e = (unsigned)__builtin_amdgcn_readlane((int)mypick.x, k + g) & 16383u;
                cvv[g] = __uint_as_float((unsigned)__builtin_amdgcn_readlane((int)mypick.y, k + g)); suu[g] = __uint_as_float((unsigned)__builtin_amdgcn_readlane((int)mypick.z, k + g));
                const unsigned char* up = U8 + (size_t)e * 2048 + lane * 16; const unsigned char* vp = V8 + (size_t)e * 2048 + lane * 16;
                uw[g][0] = *(const u32x4*)up; uw[g][1] = *(const u32x4*)(up + 1024); vw[g][0] = *(const u32x4*)vp; vw[g][1] = *(const u32x4*)(vp + 1024);
            }
#pragma unroll
            for (int g = 0; g < 8; ++g) {
                f32x2 d2 = (f32x2){0.f, 0.f};
#pragma unroll
                for (int j = 0; j < 2; ++j)
#pragma unroll
                    for (int q = 0; q < 4; ++q) { const int wd = (int)uw[g][j][q];
                        d2 += __builtin_amdgcn_cvt_pk_f32_fp8(wd, false) * xe[j][2 * q]; d2 += __builtin_amdgcn_cvt_pk_f32_fp8(wd, true) * xe[j][2 * q + 1]; }
                const float d = wave_sum(d2[0] + d2[1]);
                const float cf = cvv[g] * gelu_tanh(d * suu[g]);
#pragma unroll
                for (int j = 0; j < 2; ++j)
#pragma unroll
                    for (int q = 0; q < 4; ++q) { const int wd = (int)vw[g][j][q];
                        y[j][2 * q] += __builtin_amdgcn_cvt_pk_f32_fp8(wd, false) * cf; y[j][2 * q + 1] += __builtin_amdgcn_cvt_pk_f32_fp8(wd, true) * cf; }
            }
        }
#pragma unroll
        for (int j = 0; j < 2; ++j)
#pragma unroll
            for (int q = 0; q < 4; ++q) *(f32x4*)(lds + w * 2048 + j * 1024 + lane * 16 + q * 4) = (f32x4){y[j][2 * q][0], y[j][2 * q][1], y[j][2 * q + 1][0], y[j][2 * q + 1][1]};
        __syncthreads();
        {
            const int c0 = threadIdx.x * 4; f32x4 acc = *(const f32x4*)(lds + c0);
#pragma unroll
            for (int ww = 1; ww < 8; ++ww) acc += *(const f32x4*)(lds + ww * 2048 + c0);
            const u32x2 xw = *(const u32x2*)(X1B + (size_t)t * DM + c0); const f32x4 xv = (f32x4){bf_lo(xw.x), bf_hi(xw.x), bf_lo(xw.y), bf_hi(xw.y)};
            f32x4 r = xv * DN_ALPHA + acc;
            float s = wave_sum(r[0] + r[1] + r[2] + r[3]);
            if (lane == 0) lds[16384 + w] = s;
            __syncthreads();
            float tot = 0.f;
#pragma unroll
            for (int ww = 0; ww < 8; ++ww) tot += lds[16384 + ww];
            const float mean = tot * (1.0f / DM); r -= mean;
            float q = wave_sum(r[0] * r[0] + r[1] * r[1] + r[2] * r[2] + r[3] * r[3]);
            if (lane == 0) lds[16400 + w] = q;
            __syncthreads();
            float qt = 0.f;
#pragma unroll
            for (int ww = 0; ww < 8; ++ww) qt += lds[16400 + ww];
            const float rstd = rsqrtf(qt * (1.0f / DM) + LN_EPS);
            const f32x4 g = *(const f32x4*)(p.in[29] + c0), bb = *(const f32x4*)(p.in[30] + c0);
            *(f32x4*)(p.out + O_Y + (size_t)t * DM + c0) = r * rstd * g + bb;
        }
        __syncthreads();
    }
}


#ifdef DBG_DUMP
__device__ void dbg_dump(const Params& p) {
    const bf16_t* src = (const bf16_t*)(p.ws + DBG_DUMP_OFF);
    for (size_t i = (size_t)blockIdx.x * 512 + threadIdx.x; i < (size_t)TT * 1024; i += (size_t)gridDim.x * 512) {
        if (DBG_LAST <= 2 && i < 19947520 - O_CZP) p.out[O_CZP + i] = 0.f;
        const size_t r = i >> 10, c = i & 1023; p.out[O_Y + r * DM + c] = (r < TP) ? bf1(src[r * DBG_DUMP_LD + c]) : 0.f; p.out[O_Y + r * DM + 1024 + c] = 0.f; }
}
#endif

__device__ __forceinline__ void grid_bar(unsigned* words, unsigned n) {
    asm volatile("s_waitcnt vmcnt(0) lgkmcnt(0)" ::: "memory");
    __syncthreads();
    if (threadIdx.x == 0) {
        const unsigned G = gridDim.x, grp = blockIdx.x & 7u, gs = (G - grp + 7u) >> 3, ngrp = G < 8u ? G : 8u;
        __builtin_amdgcn_fence(__ATOMIC_RELEASE, "agent");
        const unsigned old = __hip_atomic_fetch_add(words + 32 * (1 + grp), 1u, __ATOMIC_RELAXED, __HIP_MEMORY_SCOPE_AGENT);
        if (old + 1u == n * gs) __hip_atomic_fetch_add(words, 1u, __ATOMIC_RELAXED, __HIP_MEMORY_SCOPE_AGENT);
        while (__hip_atomic_load(words, __ATOMIC_RELAXED, __HIP_MEMORY_SCOPE_AGENT) < n * ngrp) __builtin_amdgcn_s_sleep(1);
        __builtin_amdgcn_fence(__ATOMIC_ACQUIRE, "agent");
        asm volatile("s_waitcnt vmcnt(0)" ::: "memory");
    }
    __syncthreads();
}
extern __shared__ __attribute__((aligned(16))) unsigned char smem_raw[];

__global__ void __launch_bounds__(512, 2) fwd_kernel(Params p) {
    LAS unsigned char* lds = (LAS unsigned char*)smem_raw;
    float* ldsf = (float*)smem_raw;
    unsigned char* ws = p.ws;
    const int G = gridDim.x, c = blockIdx.x;
#ifndef ONLY_PH
#define ONLY_PH -1
#endif
    unsigned* barw = (unsigned*)(ws + W_BAR); unsigned nbar = 0;
#define UCONV(R0, R1) if (c >= G / 2) cvt_fp8_rows(p.in[27] + (size_t)(R0) * 2048, ws + W_UB + (size_t)(R0) * 2048, (float*)(ws + W_SCU) + (R0), (R1) - (R0), (c - G / 2) * 8 + (int)(threadIdx.x >> 6), (G - G / 2) * 8)
#define RUNPH_NB(n, ...) if ((ONLY_PH < 0 || ONLY_PH == (n)) && p.ph_lo <= (n) && (n) < p.ph_hi) { __VA_ARGS__; }
#define RUNPH(n, ...) if ((ONLY_PH < 0 || ONLY_PH == (n)) && p.ph_lo <= (n) && (n) < p.ph_hi) { __VA_ARGS__; if ((n) + 1 < p.ph_hi) { ++nbar; grid_bar(barw, nbar); } }
    RUNPH(0, phase0(p, ldsf))
    RUNPH(1, { Gemm g{(const bf16_t*)(ws + W_AALL), (const bf16_t*)(ws + W_BTALL), 2048, 2048, 2048};
            Epi1 e{(bf16_t*)(ws + W_Z), p.out + O_MK, p.out + O_MV, (bf16_t*)(ws + W_MKB), (bf16_t*)(ws + W_VTB)};
            SchedGrid s{32, 48, G, c, 0}; gemm_phase(lds, g, s, e);
            for (int ti = c; ti < 256; ti += G) s1_zin(p, ti, ldsf); })
    RUNPH(2, { const int nmk = G > 64 ? 32 : 0;
            if (c < nmk || nmk == 0) { Gemm g{(const bf16_t*)(ws + W_AALL), (const bf16_t*)(ws + W_BTALL), 2048, 2048, 2048};
                Epi1 e{(bf16_t*)(ws + W_Z), p.out + O_MK, p.out + O_MV, (bf16_t*)(ws + W_MKB), (bf16_t*)(ws + W_VTB)};
                SchedMKV s{nmk ? nmk : G, c}; gemm_phase(lds, g, s, e); }
            if (c >= nmk) for (int it = c - nmk; it < 672; it += G - nmk) {
                if (it < 512) p2_attn_sample(p, it, ldsf);
                else if (it < 640) p2_elem_prompt(p, it - 512);
                else p2_elem_sample(p, it - 640);
            }
            if (c >= nmk) cvt_fp8_rows(p.in[28], ws + W_VB, (float*)(ws + W_SCV), 16384, (c - nmk) * 8 + (int)(threadIdx.x >> 6), (G - nmk) * 8); })
    RUNPH(3, { Gemm g{(const bf16_t*)(ws + W_XR), (const bf16_t*)(ws + W_WGT), 1024, 256, 256};
            Epi3 e{(const bf16_t*)(ws + W_XR), (float*)(ws + W_SA), (float*)(ws + W_SU), p.in[13], p.in[15], p.in[16]};
            SchedGrid s{32, 8, G, c, 1}; gemm_phase(lds, g, s, e);
            for (int ti = c; ti < 64; ti += G) s3_gates(p, ti);
            if (G == 256) { int pm_, pn_; std_tile(c, 32, 8, pm_, pn_); asm volatile("s_waitcnt vmcnt(0)" ::: "memory"); __syncthreads(); p4a_tile(p, pm_, pn_); }
            for (int it = c; it < 256; it += G) { const int itx = (G == 256) ? (((it & 7) * 2 + (it >> 7)) << 4) + ((it >> 3) & 15) : it; p2_attn_prompt(p, itx); } })
    if (G != 256) { RUNPH(4, p4a(p)) }
    RUNPH(5, p4b(p))
    RUNPH(6, { Gemm g{(const bf16_t*)(ws + W_YCAT), (const bf16_t*)(ws + W_WBRT), 1024, 1024, 1024};
            Epi5 e{(const bf16_t*)(ws + W_Z), (bf16_t*)(ws + W_MF), (bf16_t*)(ws + W_MF) + (size_t)TPAD * DM, (bf16_t*)(ws + W_MB)};
            Sched5 s{G, c}; gemm_phase(lds, g, s, e);
            for (int ti = c; ti < 128; ti += G) s5_merge(p, ti, ldsf);
            UCONV(0, 5461); })
    RUNPH(7, { Gemm g{(const bf16_t*)(ws + W_MB), (const bf16_t*)(ws + W_WOT), 2048, 2048, 2048};
            EpiF e{(float*)(ws + W_H1), 2048};
            SchedGrid s{32, 8, G, c, 0}; gemm_phase(lds, g, s, e);
            for (int ti = c; ti < 128; ti += G) s68_plain(p, ti, W_MB, W_WOT, (float*)(ws + W_H1), nullptr, ldsf);
            UCONV(5461, 10922); })
    RUNPH(8, p7(p, ldsf))
    RUNPH(9, { Gemm g{(const bf16_t*)(ws + W_X1B), (const bf16_t*)(ws + W_WQT), 2048, 2048, 2048};
            EpiB e{(bf16_t*)(ws + W_QP), 2048};
            SchedGrid s{32, 8, G, c, 0}; gemm_phase(lds, g, s, e);
            for (int ti = c; ti < 128; ti += G) s68_plain(p, ti, W_X1B, W_WQT, nullptr, (bf16_t*)(ws + W_QP), ldsf);
            UCONV(10922, 16384); })
    RUNPH_NB(10, { Gemm g{(const bf16_t*)(ws + W_QP), (const bf16_t*)(ws + W_WKT), 2048, 256, 256};
            EpiF e{(float*)(ws + W_SC), 2048};
            SchedGrid s{32, 8, G, c, 2}; gemm_phase(lds, g, s, e);
            for (int ti = c; ti < 64; ti += G) s9_scores(p, ti); })
    if (p.ph_lo <= 10 && 11 < p.ph_hi) { ++nbar; grid_bar(barw, nbar); }
    RUNPH(11, p9b(p, 0))
    RUNPH(12, p10(p, ldsf))
    if (p.ph_hi > 4096) cg::this_grid().sync();
#ifdef DBG_DUMP
    RUNPH(13, dbg_dump(p))
#endif
}

#ifndef N_LAUNCH_PER_PHASE
#define N_LAUNCH_PER_PHASE 0
#endif

extern "C" void kernel_launch(void* const* d_in, const int* in_sizes, int n_in, void* d_out, int out_size, void* d_ws, size_t ws_size, hipStream_t stream) {
    constexpr int LDS_BYTES = STAGE_BYTES;
    static int grid = 0;
    if (grid == 0) {
        if (n_in != 31 || ws_size < W_END) { fprintf(stderr, "kernel_launch: unexpected n_in %d / ws_size %zu (need %zu)\n", n_in, ws_size, (size_t)W_END); grid = -1; return; }
        int dev = 0, cus = 0, per_cu = 0;
        hipGetDevice(&dev); hipDeviceGetAttribute(&cus, hipDeviceAttributeMultiprocessorCount, dev);
        if (hipFuncSetAttribute((const void*)fwd_kernel, hipFuncAttributeMaxDynamicSharedMemorySize, LDS_BYTES) != hipSuccess) { fprintf(stderr, "hipFuncSetAttribute failed\n"); grid = -1; return; }
        if (hipOccupancyMaxActiveBlocksPerMultiprocessor(&per_cu, (const void*)fwd_kernel, 512, LDS_BYTES) != hipSuccess || per_cu < 1) { fprintf(stderr, "occupancy query failed (%d)\n", per_cu); per_cu = 1; }
        (void)hipGetLastError();
        grid = cus * (per_cu > 1 ? 1 : per_cu);
    }
    if (grid < 0) return;
    Params p{};
    for (int i = 0; i < 31; ++i) p.in[i] = (const float*)d_in[i];
    p.out = (float*)d_out; p.ws = (unsigned char*)d_ws;
#if N_LAUNCH_PER_PHASE
    #ifdef DBG_DUMP
    for (int ph = 0; ph < DBG_LAST; ++ph) { p.ph_lo = ph; p.ph_hi = ph + 1; hipLaunchKernelGGL(fwd_kernel, dim3(grid), dim3(512), LDS_BYTES, stream, p); }
    p.ph_lo = 13; p.ph_hi = 14; hipLaunchKernelGGL(fwd_kernel, dim3(grid), dim3(512), LDS_BYTES, stream, p);
#else
    for (int ph = 0; ph < NPH; ++ph) { p.ph_lo = ph; p.ph_hi = ph + 1; hipLaunchKernelGGL(fwd_kernel, dim3(grid), dim3(512), LDS_BYTES, stream, p); }
#endif
#else
    p.ph_lo = 0; p.ph_hi = NPH;
    (void)hipMemsetAsync((char*)d_ws + W_BAR, 0, 2048, stream);
    void* args[] = {&p};
    hipError_t e = hipLaunchCooperativeKernel((const void*)fwd_kernel, dim3(grid), dim3(512), args, LDS_BYTES, stream);
    if (e != hipSuccess) fprintf(stderr, "cooperative launch failed: %s (grid %d)\n", hipGetErrorString(e), grid);
#endif
}
```

```cpp
#define DBG_DUMP_OFF (W_YCAT + (size_t)2 * TPAD * 1024 * 2)
#define DBG_DUMP_LD 1024
#define DBG_LAST 6
#define REPMASK 0
#include <hip/hip_runtime.h>
#include <hip/hip_cooperative_groups.h>
#include <cstdio>
namespace cg = cooperative_groups;

#define LAS __attribute__((address_space(3)))
typedef unsigned short bf16_t;
typedef short bf16x8 __attribute__((ext_vector_type(8)));
typedef float f32x4 __attribute__((ext_vector_type(4)));
typedef float f32x2 __attribute__((ext_vector_type(2)));
typedef unsigned u32x4 __attribute__((ext_vector_type(4)));
typedef unsigned u32x2 __attribute__((ext_vector_type(2)));

constexpr int DM = 2048, TP = 8192, TS = 128, TT = 8320, TPAD = 8448, NMEM = 1024, INW = 12288;
constexpr int NPH = 13;
constexpr float DN_ALPHA = 1.189207115002721f;
constexpr float LN_EPS = 1e-5f;
constexpr size_t O_Y = 0, O_MK = 17039360, O_MV = 18087936, O_CZP = 19136512, O_RCP = 19144704, O_HP = 19156992,
                 O_CZS = 19161088, O_RCS = 19423232, O_HS = 19816448;
constexpr size_t al256(size_t x) { return (x + 255) & ~(size_t)255; }
constexpr size_t W_AALL = 0;
constexpr size_t W_BTALL = W_AALL + (size_t)9472 * 2048 * 2;
constexpr size_t W_WBRT = W_BTALL + (size_t)14336 * 2048 * 2;
constexpr size_t W_WOT = W_WBRT + (size_t)3 * 2048 * 1024 * 2;
constexpr size_t W_WQT = W_WOT + (size_t)2048 * 2048 * 2;
constexpr size_t W_WGT = W_WQT + (size_t)2048 * 2048 * 2;
constexpr size_t W_WKT = W_WGT + (size_t)2048 * 256 * 2;
constexpr size_t W_UB = W_WKT + (size_t)2048 * 256 * 2;
constexpr size_t W_VB = W_UB + (size_t)16384 * 2048 * 2;
constexpr size_t W_Z = W_VB + (size_t)16384 * 2048 * 2;
constexpr size_t W_MKB = W_Z + (size_t)TPAD * INW * 2;
constexpr size_t W_VTB = W_MKB + (size_t)1024 * 1024 * 2;
constexpr size_t W_YCAT = W_VTB + (size_t)1024 * 1024 * 2;
constexpr size_t W_XR = W_YCAT + (size_t)3 * TPAD * 1024 * 2;
constexpr size_t W_SA = W_XR + (size_t)TPAD * 1024 * 2;
constexpr size_t W_SU = W_SA + (size_t)TPAD * 1024 * 4;
constexpr size_t W_CHK = W_SU + (size_t)TPAD * 1024 * 4;
constexpr size_t W_MF = W_CHK + (size_t)2 * 4 * 32 * 1024 * 4;
constexpr size_t W_MB = W_MF + (size_t)TPAD * DM * 4;
constexpr size_t W_SCU = W_MB + (size_t)TPAD * DM * 2;
constexpr size_t W_SCV = W_SCU + 16384 * 4;
constexpr size_t W_BAR = W_SCV + 16384 * 4;
constexpr size_t W_END = W_BAR + 2048;
constexpr size_t W_H1 = W_Z;
constexpr size_t W_X1F = W_Z + (size_t)TPAD * DM * 4;
constexpr size_t W_X1B = W_X1F + (size_t)TPAD * DM * 4;
constexpr size_t W_QP = W_YCAT;
constexpr size_t W_SC = W_MF;
constexpr size_t W_PICKS = W_SA;
static_assert(W_X1B + (size_t)TPAD * DM * 2 <= W_MKB, "alias overflow");
static_assert((size_t)TPAD * DM * 2 <= (size_t)3 * TPAD * 1024 * 2, "alias overflow");

struct Params {
    const float* in[31];
    float* out;
    unsigned char* ws;
    int ph_lo, ph_hi;
};

typedef __bf16 bf16x2_t __attribute__((ext_vector_type(2)));
__device__ __forceinline__ unsigned cvt_pk_bf16(float lo, float hi) { const f32x2 v = {lo, hi}; return __builtin_bit_cast(unsigned, __builtin_convertvector(v, bf16x2_t)); }
__device__ __forceinline__ float bf_lo(unsigned w) { return __uint_as_float(w << 16); }
__device__ __forceinline__ float bf_hi(unsigned w) { return __uint_as_float(w & 0xffff0000u); }
__device__ __forceinline__ float bf1(bf16_t b) { return __uint_as_float(((unsigned)b) << 16); }
__device__ __forceinline__ bf16_t f2bf(float f) { return (bf16_t)(cvt_pk_bf16(f, 0.f) & 0xffffu); }
__device__ __forceinline__ void unpack8(u32x4 w, float* v) {
    v[0] = bf_lo(w.x); v[1] = bf_hi(w.x); v[2] = bf_lo(w.y); v[3] = bf_hi(w.y); v[4] = bf_lo(w.z); v[5] = bf_hi(w.z); v[6] = bf_lo(w.w); v[7] = bf_hi(w.w);
}
__device__ __forceinline__ u32x4 pack8(const float* v) {
    u32x4 w; w.x = cvt_pk_bf16(v[0], v[1]); w.y = cvt_pk_bf16(v[2], v[3]); w.z = cvt_pk_bf16(v[4], v[5]); w.w = cvt_pk_bf16(v[6], v[7]); return w;
}
__device__ __forceinline__ float fast_exp(float x) { return __builtin_amdgcn_exp2f(x * 1.4426950408889634f); }
__device__ __forceinline__ float sigmoidf_(float x) { return __builtin_amdgcn_rcpf(1.0f + fast_exp(-x)); }
__device__ __forceinline__ float gelu_tanh(float x) {
    const float z = 0.7978845608028654f * (x + 0.044715f * x * x * x);
    const float th = 1.0f - 2.0f * __builtin_amdgcn_rcpf(1.0f + fast_exp(2.0f * z));
    return 0.5f * x * (1.0f + th);
}
__device__ __forceinline__ int launder_tid() { int t = threadIdx.x; asm volatile("" : "+v"(t)); return t; }
__device__ __forceinline__ float wave_sum(float v) {
#pragma unroll
    for (int o = 32; o > 0; o >>= 1) v += __shfl_xor(v, o, 64);
    return v;
}

constexpr int BM = 256, BK = 64, HALF = 128, HTB = HALF * BK * 2, STAGE_BYTES = 8 * HTB, NXCD = 8, WGM = 4;
__device__ __forceinline__ int lds_byte(int r, int c) { const int st = (r >> 4) * 2 + (c >> 5), rr = r & 15, cc = c & 31, ob = rr * 64 + cc * 2; return st * 1024 + (ob ^ (((ob >> 9) & 1) << 5)); }
__device__ __forceinline__ void stage_rc(int b, int& R, int& C) { const int st = b / 1024, sb = b % 1024, swz = sb ^ (((sb >> 9) & 1) << 5); R = (st >> 1) * 16 + swz / 64; C = (st & 1) * 32 + (swz % 64) / 2; }
__device__ __forceinline__ int perm32(int rho) { const int n = rho >> 4, i = rho & 15; return 8 * (i >> 2) + 4 * n + (i & 3); }

struct Unit { int pm, pn, ka; };
struct Gemm { const bf16_t* A; const bf16_t* Bt; int lda, ldb, K; };

__device__ __forceinline__ void std_tile(int L, int nM, int nN, int& pm, int& pn) {
    const int nwg = nM * nN; int wgid = L;
    { const int q = nwg / NXCD, r = nwg % NXCD, xcd = wgid % NXCD, off = wgid / NXCD; wgid = (xcd < r ? xcd * (q + 1) : r * (q + 1) + (xcd - r) * q) + off; }
    const int nig = WGM * nN, gid = wgid / nig, fm = gid * WGM, gsz = (nM - fm) < WGM ? (nM - fm) : WGM;
    pm = fm + ((wgid % nig) % gsz); pn = (wgid % nig) / gsz;
}

template <class Epi, class Sched>
__device__ __forceinline__ void gemm_phase(LAS unsigned char* lds, const Gemm g, const Sched& S, const Epi& E) {
    const int tid = threadIdx.x, wid = __builtin_amdgcn_readfirstlane(tid >> 6), lane = tid & 63, wr = wid >> 2, wc = wid & 3, fr = lane & 15, fq = lane >> 4;
    const int K = g.K, nt = K / BK;
    unsigned voffA[2], voffB[2];
#pragma unroll
    for (int i = 0; i < 2; ++i) { int R, C; stage_rc(tid * 16 + i * 8192, R, C); const int Rb = Epi::PERM ? ((R & ~31) + perm32(R & 31)) : R;
        voffA[i] = (unsigned)(R * g.lda + C) * 2u; voffB[i] = (unsigned)(Rb * g.ldb + C) * 2u; }
    const size_t kstep = (size_t)(BK * 2);
    const size_t hstepA = (size_t)HALF * g.lda * 2, hstepB = (size_t)HALF * g.ldb * 2;
    const size_t tstepA = 2 * hstepA, tstepB = 2 * hstepB;
    const unsigned ldsw = (unsigned)wid * 1024u;
    const int aoff = lds_byte(wr * 64 + fr, fq * 8), boff = lds_byte(wc * 32 + fr, fq * 8);
#define PG8_SA(b, h) (((b) * 2 + (h)) * HTB)
#define PG8_SB(b, h) ((4 + (b) * 2 + (h)) * HTB)
#define PG8_STAGE(bufoff, gbase, voff) do { _Pragma("unroll") for (int _i = 0; _i < 2; ++_i) \
        __builtin_amdgcn_global_load_lds((const unsigned*)((const char*)(gbase) + (voff)[_i]), (LAS unsigned*)(lds + (bufoff) + ldsw + _i * 8192), 16, 0, 0); } while (0)
#define PG8_LDA(dst, b, h) do { _Pragma("unroll") for (int m = 0; m < 4; ++m) _Pragma("unroll") for (int k = 0; k < 2; ++k) dst[m][k] = *(const LAS bf16x8*)(lds + PG8_SA(b, h) + aoff + m * 2048 + k * 1024); } while (0)
#define PG8_LDB(dst, b, h) do { _Pragma("unroll") for (int n = 0; n < 2; ++n) _Pragma("unroll") for (int k = 0; k < 2; ++k) dst[n][k] = *(const LAS bf16x8*)(lds + PG8_SB(b, h) + boff + n * 2048 + k * 1024); } while (0)
#define PG8_MMA(ai, bj, At, Bt) do { __builtin_amdgcn_s_setprio(1); _Pragma("unroll") for (int m = 0; m < 4; ++m) _Pragma("unroll") for (int n = 0; n < 2; ++n) _Pragma("unroll") for (int k = 0; k < 2; ++k) \
        acc[ai][bj][m][n] = __builtin_amdgcn_mfma_f32_16x16x32_bf16(Bt[n][k], At[m][k], acc[ai][bj][m][n], 0, 0, 0); __builtin_amdgcn_s_setprio(0); } while (0)
#define PG8_WAIT_V(n) asm volatile("s_waitcnt vmcnt(" #n ")" ::: "memory")
#define PG8_WAIT_L(n) asm volatile("s_waitcnt lgkmcnt(" #n ")" ::: "memory")
#define PG8_BAR __builtin_amdgcn_s_barrier()
#define PG8_SCHED __builtin_amdgcn_sched_barrier(0)
    Unit cur, nxt; int ui = 0;
    if (!S.next(0, cur)) return;
    f32x4 acc[2][2][4][2];
#pragma unroll
    for (int a = 0; a < 2; ++a)
#pragma unroll
        for (int b = 0; b < 2; ++b)
#pragma unroll
            for (int m = 0; m < 4; ++m)
#pragma unroll
                for (int n = 0; n < 2; ++n) acc[a][b][m][n] = (f32x4){0.f, 0.f, 0.f, 0.f};
    bf16x8 At[4][2], B0[2][2], B1[2][2];
    const char* cA = (const char*)g.A + (size_t)cur.pm * tstepA + (size_t)cur.ka * 2; const char* cB = (const char*)g.Bt + (size_t)cur.pn * tstepB;
    PG8_STAGE(PG8_SB(0, 0), cB, voffB); PG8_STAGE(PG8_SA(0, 0), cA, voffA); PG8_STAGE(PG8_SB(0, 1), cB + hstepB, voffB); PG8_STAGE(PG8_SA(0, 1), cA + hstepA, voffA);
    if (wr == 1) PG8_BAR;
    PG8_WAIT_V(4); PG8_BAR;
    PG8_STAGE(PG8_SB(1, 0), cB + kstep, voffB); PG8_STAGE(PG8_SA(1, 0), cA + kstep, voffA); PG8_STAGE(PG8_SB(1, 1), cB + hstepB + kstep, voffB);
    PG8_WAIT_V(6); PG8_BAR;
    for (;;) {
        const bool has_next = S.next(ui + 1, nxt);
        const char* nA = has_next ? (const char*)g.A + (size_t)nxt.pm * tstepA + (size_t)nxt.ka * 2 : cA; const char* nB = has_next ? (const char*)g.Bt + (size_t)nxt.pn * tstepB : cB;
        for (int t = 0; t < nt; t += 2) {
            const bool last = (t == nt - 2);
            const char* a1 = cA + (size_t)(t + 1) * kstep;
            const char* a2 = last ? nA : cA + (size_t)(t + 2) * kstep; const char* b2 = last ? nB : cB + (size_t)(t + 2) * kstep;
            const char* a3 = a2 + kstep; const char* b3 = b2 + kstep;
            PG8_LDB(B0, 0, 0); PG8_SCHED; PG8_LDA(At, 0, 0); PG8_STAGE(PG8_SA(1, 1), a1 + hstepA, voffA);
            PG8_WAIT_L(8); PG8_BAR; PG8_WAIT_L(0); PG8_MMA(0, 0, At, B0); PG8_BAR; PG8_SCHED;
            PG8_LDB(B1, 0, 1); PG8_STAGE(PG8_SB(0, 0), b2, voffB);
            PG8_BAR; PG8_WAIT_L(0); PG8_MMA(0, 1, At, B1); PG8_BAR;
            PG8_LDA(At, 0, 1); PG8_STAGE(PG8_SA(0, 0), a2, voffA);
            PG8_BAR; PG8_WAIT_L(0); PG8_MMA(1, 0, At, B0); PG8_BAR; PG8_SCHED;
            PG8_STAGE(PG8_SB(0, 1), b2 + hstepB, voffB);
            PG8_WAIT_V(6); PG8_BAR; PG8_MMA(1, 1, At, B1); PG8_BAR;
            PG8_LDB(B0, 1, 0); PG8_SCHED; PG8_LDA(At, 1, 0); PG8_STAGE(PG8_SA(0, 1), a2 + hstepA, voffA);
            PG8_WAIT_L(8); PG8_BAR; PG8_WAIT_L(0); PG8_MMA(0, 0, At, B0); PG8_BAR; PG8_SCHED;
            PG8_LDB(B1, 1, 1); PG8_STAGE(PG8_SB(1, 0), b3, voffB);
            PG8_BAR; PG8_WAIT_L(0); PG8_MMA(0, 1, At, B1); PG8_BAR;
            PG8_LDA(At, 1, 1); PG8_STAGE(PG8_SA(1, 0), a3, voffA);
            PG8_BAR; PG8_WAIT_L(0); PG8_MMA(1, 0, At, B0); PG8_BAR; PG8_SCHED;
            PG8_STAGE(PG8_SB(1, 1), b3 + hstepB, voffB);
            PG8_WAIT_V(6); PG8_BAR; PG8_MMA(1, 1, At, B1); PG8_BAR;
        }
        E(acc, cur, wr, wc, fr, fq);
        if (!has_next) break;
#pragma unroll
        for (int a = 0; a < 2; ++a)
#pragma unroll
            for (int b = 0; b < 2; ++b)
#pragma unroll
                for (int m = 0; m < 4; ++m)
#pragma unroll
                    for (int n = 0; n < 2; ++n) acc[a][b][m][n] = (f32x4){0.f, 0.f, 0.f, 0.f};
        cur = nxt; cA = nA; cB = nB; ++ui;
    }
    PG8_WAIT_V(0);
    if (wr == 0) PG8_BAR;
    PG8_BAR;
#undef PG8_SA
#undef PG8_SB
#undef PG8_STAGE
#undef PG8_LDA
#undef PG8_LDB
#undef PG8_MMA
#undef PG8_WAIT_V
#undef PG8_WAIT_L
#undef PG8_BAR
#undef PG8_SCHED
}

struct SchedGrid {
    int nM, nN, G, c, kaMode;
    __device__ bool next(int i, Unit& u) const {
        const int L = i * G + c; if (L >= nM * nN) return false;
        std_tile(L, nM, nN, u.pm, u.pn);
        u.ka = kaMode == 0 ? 0 : (kaMode == 1 ? (u.pn & ~1) * 128 : u.pn * 256);
        return true;
    }
};
struct Sched1 {
    int G, c;
    __device__ bool next(int i, Unit& u) const {
        const int L = i * G + c; u.ka = 0;
        if (L < 32 * 48) { std_tile(L, 32, 48, u.pm, u.pn); return true; }
        const int j = L - 32 * 48; if (j >= 32) return false;
        u.pm = 33 + (j >> 3); u.pn = 48 + (j & 7); return true;
    }
};
struct SchedMKV {
    int G, c;
    __device__ bool next(int i, Unit& u) const { const int L = i * G + c; if (L >= 32) return false; u.pm = 33 + (L >> 3); u.pn = 48 + (L & 7); u.ka = 0; return true; }
};
struct Sched5 {
    int G, c;
    __device__ bool next(int i, Unit& u) const {
        const int T = (i / 3) * G + c, j = i % 3; if (T >= 32 * 8) return false;
        int pm, pn; std_tile(T, 32, 8, pm, pn);
        u.pm = j * 33 + pm; u.pn = j * 8 + pn; u.ka = 0; return true;
    }
};

struct Epi1 {
    static constexpr bool PERM = true;
    bf16_t* Z; float* omk; float* omv; bf16_t* MKB; bf16_t* VTB;
    __device__ __forceinline__ void operator()(const f32x4 (&acc)[2][2][4][2], const Unit& u, int wr, int wc, int fr, int fq) const {
        if (u.pn < 48) {
            const int row0 = u.pm * BM + wr * 64 + fr, col0 = u.pn * BM + wc * 32 + 8 * fq;
#pragma unroll
            for (int ai = 0; ai < 2; ++ai)
#pragma unroll
                for (int m = 0; m < 4; ++m) { bf16_t* rowp = Z + (size_t)(row0 + ai * HALF + m * 16) * INW + col0;
#pragma unroll
                    for (int bj = 0; bj < 2; ++bj) { const f32x4 v0 = acc[ai][bj][m][0], v1 = acc[ai][bj][m][1];
                        u32x4 w; w.x = cvt_pk_bf16(v0[0], v0[1]); w.y = cvt_pk_bf16(v0[2], v0[3]); w.z = cvt_pk_bf16(v1[0], v1[1]); w.w = cvt_pk_bf16(v1[2], v1[3]);
                        *(u32x4*)(rowp + bj * HALF) = w; } }
        } else {
            const int row0 = (u.pm - 33) * BM + wr * 64 + fr, col0 = (u.pn - 48) * BM + wc * 32 + 8 * fq;
            const bool isv = (u.pn - 48) >= 4;
#pragma unroll
            for (int ai = 0; ai < 2; ++ai)
#pragma unroll
                for (int m = 0; m < 4; ++m) { const int row = row0 + ai * HALF + m * 16;
#pragma unroll
                    for (int bj = 0; bj < 2; ++bj) { const f32x4 v0 = acc[ai][bj][m][0], v1 = acc[ai][bj][m][1]; const int col = col0 + bj * HALF;
                        if (!isv) {
                            float* o = omk + (size_t)row * 1024 + col; *(f32x4*)o = v0; *(f32x4*)(o + 4) = v1;
                            u32x4 w; w.x = cvt_pk_bf16(v0[0], v0[1]); w.y = cvt_pk_bf16(v0[2], v0[3]); w.z = cvt_pk_bf16(v1[0], v1[1]); w.w = cvt_pk_bf16(v1[2], v1[3]);
                            *(u32x4*)(MKB + (size_t)row * 1024 + col) = w;
                        } else {
                            const int cm = col - 1024; float* o = omv + (size_t)row * 1024 + cm; *(f32x4*)o = v0; *(f32x4*)(o + 4) = v1;
                            bf16_t* vt = VTB + ((size_t)(row >> 8) * 1024 + cm) * 256 + (row & 255);
#pragma unroll
                            for (int e = 0; e < 4; ++e) { vt[(size_t)e * 256] = f2bf(v0[e]); vt[(size_t)(e + 4) * 256] = f2bf(v1[e]); }
                        } } }
        }
    }
};
struct Epi3 {
    static constexpr bool PERM = false;
    const bf16_t* __restrict__ XR; float* __restrict__ SA; float* __restrict__ SU; const float* ba; const float* bx; const float* lam;
    __device__ __forceinline__ void operator()(const f32x4 (&acc)[2][2][4][2], const Unit& u, int wr, int wc, int fr, int fq) const {
        const int row0 = u.pm * BM + wr * 64 + fr, ch0 = u.pn * 128 + wc * 32 + 4 * fq;
        u32x2 xw[2][2][4];
#pragma unroll
        for (int n = 0; n < 2; ++n)
#pragma unroll
            for (int ai = 0; ai < 2; ++ai)
#pragma unroll
                for (int m = 0; m < 4; ++m) xw[n][ai][m] = *(const u32x2*)(XR + (size_t)(row0 + ai * HALF + m * 16) * 1024 + ch0 + n * 16);
#pragma unroll
        for (int n = 0; n < 2; ++n) {
            const int ch = ch0 + n * 16;
            const f32x4 vba = *(const f32x4*)(ba + ch), vbx = *(const f32x4*)(bx + ch), l = *(const f32x4*)(lam + ch); f32x4 vsp;
#pragma unroll
            for (int j = 0; j < 4; ++j) { const float ex = fast_exp(-l[j]);
                const float sp = ex < 0.03f ? ex * (1.0f + ex * (-0.5f + ex * (0.33333333f - 0.25f * ex))) : __logf(1.0f + ex); vsp[j] = -8.0f * sp; }
#pragma unroll
            for (int ai = 0; ai < 2; ++ai)
#pragma unroll
                for (int m = 0; m < 4; ++m) { const int row = row0 + ai * HALF + m * 16; if (row >= TT) continue;
                    const u32x2 xv = xw[n][ai][m];
                    const float xr[4] = {bf_lo(xv.x), bf_hi(xv.x), bf_lo(xv.y), bf_hi(xv.y)}; f32x4 av, uv;
#pragma unroll
                    for (int j = 0; j < 4; ++j) { const float r = sigmoidf_(acc[ai][0][m][n][j] + vba[j]), ig = sigmoidf_(acc[ai][1][m][n][j] + vbx[j]);
                        const float la = vsp[j] * r; av[j] = fast_exp(la); uv[j] = __builtin_amdgcn_sqrtf(fmaxf(1.0f - av[j] * av[j], 0.f)) * ig * xr[j]; }
                    *(f32x4*)(SA + (size_t)row * 1024 + ch) = av; *(f32x4*)(SU + (size_t)row * 1024 + ch) = uv; }
        }
    }
};
struct Epi5 {
    static constexpr bool PERM = true;
    const bf16_t* __restrict__ Z; bf16_t* __restrict__ P0; bf16_t* __restrict__ P1; bf16_t* __restrict__ MB;
    __device__ __forceinline__ void operator()(const f32x4 (&acc)[2][2][4][2], const Unit& u, int wr, int wc, int fr, int fq) const {
        const int j = u.pn >> 3, pm = u.pm - j * 33, pn = u.pn & 7;
        const int row0 = pm * BM + wr * 64 + fr, col0 = pn * BM + wc * 32 + 8 * fq;
        const bf16_t* __restrict__ src = (j == 1) ? P0 : P1; bf16_t* __restrict__ dst = (j == 0) ? P0 : (j == 1 ? P1 : MB);
#pragma unroll
        for (int ai = 0; ai < 2; ++ai) {
            u32x4 gw[4][2], pw[4][2];
#pragma unroll
            for (int m = 0; m < 4; ++m)
#pragma unroll
                for (int bj = 0; bj < 2; ++bj) { const int row = row0 + ai * HALF + m * 16, col = col0 + bj * HALF;
                    gw[m][bj] = *(const u32x4*)(Z + (size_t)row * INW + 6144 + j * 2048 + col);
                    pw[m][bj] = (j > 0) ? *(const u32x4*)(src + (size_t)row * DM + col) : (u32x4){0u, 0u, 0u, 0u}; }
#pragma unroll
            for (int m = 0; m < 4; ++m)
#pragma unroll
                for (int bj = 0; bj < 2; ++bj) { const int row = row0 + ai * HALF + m * 16, col = col0 + bj * HALF;
                    float gv[8], pv[8], r[8]; unpack8(gw[m][bj], gv); unpack8(pw[m][bj], pv);
#pragma unroll
                    for (int e = 0; e < 4; ++e) { r[e] = sigmoidf_(gv[e]) * acc[ai][bj][m][0][e] + pv[e]; r[e + 4] = sigmoidf_(gv[e + 4]) * acc[ai][bj][m][1][e] + pv[e + 4]; }
                    *(u32x4*)(dst + (size_t)row * DM + col) = pack8(r); }
        }
    }
};
struct Epi6 {
    static constexpr bool PERM = false;
    const float* xp; const float* xs; float* H1;
    __device__ __forceinline__ void operator()(const f32x4 (&acc)[2][2][4][2], const Unit& u, int wr, int wc, int fr, int fq) const {
        const int row0 = u.pm * BM + wr * 64 + fr, col0 = u.pn * BM + wc * 32 + 4 * fq;
#pragma unroll
        for (int ai = 0; ai < 2; ++ai)
#pragma unroll
            for (int m = 0; m < 4; ++m) { const int row = row0 + ai * HALF + m * 16; if (row >= TT) continue;
                const float* xrow = row < TP ? xp + (size_t)row * DM : xs + (size_t)(row - TP) * DM;
#pragma unroll
                for (int bj = 0; bj < 2; ++bj)
#pragma unroll
                    for (int n = 0; n < 2; ++n) { const int col = col0 + bj * HALF + n * 16; const f32x4 xv = *(const f32x4*)(xrow + col);
                        *(f32x4*)(H1 + (size_t)row * DM + col) = xv * DN_ALPHA + acc[ai][bj][m][n]; } }
    }
};
struct EpiB {
    static constexpr bool PERM = true;
    bf16_t* O; int ldc;
    __device__ __forceinline__ void operator()(const f32x4 (&acc)[2][2][4][2], const Unit& u, int wr, int wc, int fr, int fq) const {
        const int row0 = u.pm * BM + wr * 64 + fr, col0 = u.pn * BM + wc * 32 + 8 * fq;
#pragma unroll
        for (int ai = 0; ai < 2; ++ai)
#pragma unroll
            for (int m = 0; m < 4; ++m) { bf16_t* rowp = O + (size_t)(row0 + ai * HALF + m * 16) * ldc + col0;
#pragma unroll
                for (int bj = 0; bj < 2; ++bj) { const f32x4 v0 = acc[ai][bj][m][0], v1 = acc[ai][bj][m][1];
                    u32x4 w; w.x = cvt_pk_bf16(v0[0], v0[1]); w.y = cvt_pk_bf16(v0[2], v0[3]); w.z = cvt_pk_bf16(v1[0], v1[1]); w.w = cvt_pk_bf16(v1[2], v1[3]);
                    *(u32x4*)(rowp + bj * HALF) = w; } }
    }
};
struct EpiF {
    static constexpr bool PERM = false;
    float* C; int ldc;
    __device__ __forceinline__ void operator()(const f32x4 (&acc)[2][2][4][2], const Unit& u, int wr, int wc, int fr, int fq) const {
        const int row0 = u.pm * BM + wr * 64 + fr, col0 = u.pn * BM + wc * 32 + 4 * fq;
#pragma unroll
        for (int ai = 0; ai < 2; ++ai)
#pragma unroll
            for (int m = 0; m < 4; ++m) { float* rowp = C + (size_t)(row0 + ai * HALF + m * 16) * ldc + col0;
#pragma unroll
                for (int bj = 0; bj < 2; ++bj)
#pragma unroll
                    for (int n = 0; n < 2; ++n) *(f32x4*)(rowp + bj * HALF + n * 16) = acc[ai][bj][m][n]; }
    }
};

__device__ void cvt_flat(const float* __restrict__ src, bf16_t* __restrict__ dst, size_t n, size_t gtid, size_t gth) {
    for (size_t i = gtid * 8; i < n; i += gth * 8) {
        const f32x4 a = *(const f32x4*)(src + i), b = *(const f32x4*)(src + i + 4);
        u32x4 w; w.x = cvt_pk_bf16(a[0], a[1]); w.y = cvt_pk_bf16(a[2], a[3]); w.z = cvt_pk_bf16(b[0], b[1]); w.w = cvt_pk_bf16(b[2], b[3]);
        *(u32x4*)(dst + i) = w;
    }
}
__device__ void transpose_cvt(float* lds, const float* __restrict__ src, bf16_t* __restrict__ dst, int K, int N, int bid, int nb) {
    const int tn = N / 64, ntile = (K / 64) * tn;
    for (int t = bid; t < ntile; t += nb) {
        const int k0 = (t / tn) * 64, n0 = (t % tn) * 64;
#pragma unroll
        for (int i = 0; i < 2; ++i) { const int idx = threadIdx.x + i * 512, r = idx >> 4, c4 = (idx & 15) * 4;
            const f32x4 v = *(const f32x4*)(src + (size_t)(k0 + r) * N + n0 + c4);
            lds[r * 65 + c4] = v[0]; lds[r * 65 + c4 + 1] = v[1]; lds[r * 65 + c4 + 2] = v[2]; lds[r * 65 + c4 + 3] = v[3]; }
        __syncthreads();
        { const int n = threadIdx.x >> 3, kc = (threadIdx.x & 7) * 8; float v[8];
#pragma unroll
            for (int i = 0; i < 8; ++i) v[i] = lds[(kc + i) * 65 + n];
            *(u32x4*)(dst + (size_t)(n0 + n) * K + k0 + kc) = pack8(v); }
        __syncthreads();
    }
}


__device__ void cvt_fp8_rows(const float* __restrict__ src, unsigned char* __restrict__ dst, float* __restrict__ inv, int nrows, int gw, int nw) {
    const int lane = threadIdx.x & 63;
    for (int row = gw; row < nrows; row += nw) {
        f32x4 v[2][4]; float mx = 0.f;
#pragma unroll
        for (int j = 0; j < 2; ++j)
#pragma unroll
            for (int q = 0; q < 4; ++q) { v[j][q] = *(const f32x4*)(src + (size_t)row * 2048 + j * 1024 + lane * 16 + q * 4);
                mx = fmaxf(mx, fmaxf(fmaxf(fabsf(v[j][q][0]), fabsf(v[j][q][1])), fmaxf(fabsf(v[j][q][2]), fabsf(v[j][q][3])))); }
#pragma unroll
        for (int o = 32; o > 0; o >>= 1) mx = fmaxf(mx, __shfl_xor(mx, o, 64));
        int k = 8 - ((int)((__float_as_uint(mx) >> 23) & 0xffu) - 126); k = k > 100 ? 100 : (k < -100 ? -100 : k);
        if (mx == 0.f) k = 0;
        const float sc = __uint_as_float((unsigned)(127 + k) << 23), isc = __uint_as_float((unsigned)(127 - k) << 23);
#pragma unroll
        for (int j = 0; j < 2; ++j) { u32x4 w;
#pragma unroll
            for (int q = 0; q < 4; ++q) { int t = 0; t = __builtin_amdgcn_cvt_pk_fp8_f32(v[j][q][0] * sc, v[j][q][1] * sc, t, false); t = __builtin_amdgcn_cvt_pk_fp8_f32(v[j][q][2] * sc, v[j][q][3] * sc, t, true); w[q] = (unsigned)t; }
            *(u32x4*)(dst + (size_t)row * 4096 + j * 1024 + lane * 16) = w; }
        if (lane == 0) inv[row] = isc;
    }
}

__device__ void phase0(const Params& p, float* lds) {
    const int bid = blockIdx.x, nb = gridDim.x; const size_t gtid = (size_t)bid * 512 + threadIdx.x, gth = (size_t)nb * 512;
    unsigned char* ws = p.ws;
    bf16_t* AALL = (bf16_t*)(ws + W_AALL); bf16_t* BTALL = (bf16_t*)(ws + W_BTALL);
    transpose_cvt(lds, p.in[8], BTALL, 2048, 12288, bid, nb);
    transpose_cvt(lds, p.in[17], BTALL + (size_t)12288 * 2048, 2048, 1024, bid, nb);
    transpose_cvt(lds, p.in[18], BTALL + (size_t)13312 * 2048, 2048, 1024, bid, nb);
    transpose_cvt(lds, p.in[19], (bf16_t*)(ws + W_WBRT), 1024, 2048, bid, nb);
    transpose_cvt(lds, p.in[20], (bf16_t*)(ws + W_WBRT) + (size_t)2048 * 1024, 1024, 2048, bid, nb);
    transpose_cvt(lds, p.in[21], (bf16_t*)(ws + W_WBRT) + (size_t)2 * 2048 * 1024, 1024, 2048, bid, nb);
    transpose_cvt(lds, p.in[22], (bf16_t*)(ws + W_WOT), 2048, 2048, bid, nb);
    transpose_cvt(lds, p.in[25], (bf16_t*)(ws + W_WQT), 2048, 2048, bid, nb);
    cvt_flat(p.in[0], AALL, (size_t)TP * DM, gtid, gth);
    cvt_flat(p.in[1], AALL + (size_t)TP * DM, (size_t)TS * DM, gtid, gth);
    cvt_flat(p.in[2], AALL + (size_t)TPAD * DM, (size_t)NMEM * DM, gtid, gth);
    bf16_t* WGT = (bf16_t*)(ws + W_WGT); bf16_t* WKT = (bf16_t*)(ws + W_WKT);
    for (size_t idx = gtid; idx < (size_t)2048 * 256; idx += gth) {
        const int k = (int)(idx & 255), ng = (int)(idx >> 8), h = ng >> 8, n = ng & 255;
        float v = 0.f;
        if ((k >> 7) == (h & 1)) { const float* w = (n < 128) ? p.in[12] : p.in[14]; v = w[((size_t)h * 128 + (k & 127)) * 128 + (n & 127)]; }
        WGT[idx] = f2bf(v);
        float v2 = 0.f; const int c = n >> 7;
        if ((k >> 7) == c) v2 = p.in[26][(((size_t)h * 2 + c) * 128 + (n & 127)) * 128 + (k & 127)];
        WKT[idx] = f2bf(v2);
    }
}

__device__ __forceinline__ u32x4 ldz(const bf16_t* Z, int t, int col) { return *(const u32x4*)(Z + (size_t)t * INW + col); }

__device__ void p2_elem_prompt(const Params& p, int item) {
    const int TIDX = launder_tid();
    const bf16_t* __restrict__ Z = (const bf16_t*)(p.ws + W_Z); bf16_t* __restrict__ Y0 = (bf16_t*)(p.ws + W_YCAT); bf16_t* __restrict__ XR = (bf16_t*)(p.ws + W_XR);
    const int run = item * 4 + (TIDX >> 7), c0 = (TIDX & 127) * 8, t0 = run * 16, b = t0 >> 11, s0 = t0 & 2047;
    float cw[3][8], rw[4][8], rb[8];
#pragma unroll
    for (int k = 0; k < 3; ++k) { const f32x4 a = *(const f32x4*)(p.in[9] + k * 1024 + c0), bb = *(const f32x4*)(p.in[9] + k * 1024 + c0 + 4);
#pragma unroll
        for (int e = 0; e < 4; ++e) { cw[k][e] = a[e]; cw[k][e + 4] = bb[e]; } }
#pragma unroll
    for (int k = 0; k < 4; ++k) { const f32x4 a = *(const f32x4*)(p.in[10] + k * 1024 + c0), bb = *(const f32x4*)(p.in[10] + k * 1024 + c0 + 4);
#pragma unroll
        for (int e = 0; e < 4; ++e) { rw[k][e] = a[e]; rw[k][e + 4] = bb[e]; } }
    { const f32x4 a = *(const f32x4*)(p.in[11] + c0), bb = *(const f32x4*)(p.in[11] + c0 + 4);
#pragma unroll
        for (int e = 0; e < 4; ++e) { rb[e] = a[e]; rb[e + 4] = bb[e]; } }
    float z2[8], z1[8], r3[8], r2[8], r1[8];
#pragma unroll
    for (int e = 0; e < 8; ++e) { z2[e] = z1[e] = r3[e] = r2[e] = r1[e] = 0.f; }
    if (s0 > 0) {
        float a[8], bb[8];
        unpack8(ldz(Z, t0 - 2, 1024 + c0), a); unpack8(ldz(Z, t0 - 2, 2048 + c0), bb);
#pragma unroll
        for (int e = 0; e < 8; ++e) z2[e] = a[e] * bb[e];
        unpack8(ldz(Z, t0 - 1, 1024 + c0), a); unpack8(ldz(Z, t0 - 1, 2048 + c0), bb);
#pragma unroll
        for (int e = 0; e < 8; ++e) z1[e] = a[e] * bb[e];
        unpack8(ldz(Z, t0 - 3, 3072 + c0), r3); unpack8(ldz(Z, t0 - 2, 3072 + c0), r2); unpack8(ldz(Z, t0 - 1, 3072 + c0), r1);
    }
#pragma unroll 1
    for (int sb = 0; sb < 16; sb += 4) {
        u32x4 wcb[4], wcc[4], wcx[4], wrx[4];
#pragma unroll
        for (int s = 0; s < 4; ++s) { const int t = t0 + sb + s; wcb[s] = ldz(Z, t, c0); wcc[s] = ldz(Z, t, 1024 + c0); wcx[s] = ldz(Z, t, 2048 + c0); wrx[s] = ldz(Z, t, 3072 + c0); }
#pragma unroll
        for (int s = 0; s < 4; ++s) {
            const int t = t0 + sb + s, sq = s0 + sb + s;
            float cb[8], cc[8], cx[8], rx[8], zc[8], yc[8], xr[8];
            unpack8(wcb[s], cb); unpack8(wcc[s], cc); unpack8(wcx[s], cx); unpack8(wrx[s], rx);
#pragma unroll
            for (int e = 0; e < 8; ++e) { zc[e] = cc[e] * cx[e]; yc[e] = cb[e] * (cw[0][e] * z2[e] + cw[1][e] * z1[e] + cw[2][e] * zc[e]);
                xr[e] = rw[0][e] * r3[e] + rw[1][e] * r2[e] + rw[2][e] * r1[e] + rw[3][e] * rx[e] + rb[e]; }
            *(u32x4*)(Y0 + (size_t)t * 1024 + c0) = pack8(yc);
            *(u32x4*)(XR + (size_t)t * 1024 + c0) = pack8(xr);
            if (sq >= 2046) { float* o = p.out + O_CZP + ((size_t)b * 2 + (sq - 2046)) * 1024 + c0; *(f32x4*)o = (f32x4){zc[0], zc[1], zc[2], zc[3]}; *(f32x4*)(o + 4) = (f32x4){zc[4], zc[5], zc[6], zc[7]}; }
            if (sq >= 2045) { float* o = p.out + O_RCP + ((size_t)b * 3 + (sq - 2045)) * 1024 + c0; *(f32x4*)o = (f32x4){rx[0], rx[1], rx[2], rx[3]}; *(f32x4*)(o + 4) = (f32x4){rx[4], rx[5], rx[6], rx[7]}; }
#pragma unroll
            for (int e = 0; e < 8; ++e) { z2[e] = z1[e]; z1[e] = zc[e]; r3[e] = r2[e]; r2[e] = r1[e]; r1[e] = rx[e]; }
        }
    }
}
__device__ __forceinline__ void ld8f(const float* p, float* v) { const f32x4 a = *(const f32x4*)p, b = *(const f32x4*)(p + 4);
#pragma unroll
    for (int e = 0; e < 4; ++e) { v[e] = a[e]; v[e + 4] = b[e]; } }
__device__ __forceinline__ void st8f(float* p, const float* v) { *(f32x4*)p = (f32x4){v[0], v[1], v[2], v[3]}; *(f32x4*)(p + 4) = (f32x4){v[4], v[5], v[6], v[7]}; }

__device__ void p2_elem_sample(const Params& p, int item) {
    const int TIDX = launder_tid();
    const bf16_t* Z = (const bf16_t*)(p.ws + W_Z); bf16_t* Y0 = (bf16_t*)(p.ws + W_YCAT); bf16_t* XR = (bf16_t*)(p.ws + W_XR);
    const int bs = item * 4 + (TIDX >> 7), c0 = (TIDX & 127) * 8, t = TP + bs;
    float cw[3][8], rw[4][8], rb[8], z2[8], z1[8], r3[8], r2[8], r1[8];
#pragma unroll
    for (int k = 0; k < 3; ++k) ld8f(p.in[9] + k * 1024 + c0, cw[k]);
#pragma unroll
    for (int k = 0; k < 4; ++k) ld8f(p.in[10] + k * 1024 + c0, rw[k]);
    ld8f(p.in[11] + c0, rb);
    ld8f(p.in[5] + ((size_t)bs * 2 + 0) * 1024 + c0, z2); ld8f(p.in[5] + ((size_t)bs * 2 + 1) * 1024 + c0, z1);
    ld8f(p.in[6] + ((size_t)bs * 3 + 0) * 1024 + c0, r3); ld8f(p.in[6] + ((size_t)bs * 3 + 1) * 1024 + c0, r2); ld8f(p.in[6] + ((size_t)bs * 3 + 2) * 1024 + c0, r1);
    float cb[8], cc[8], cx[8], rx[8], zc[8], yc[8], xr[8];
    unpack8(ldz(Z, t, c0), cb); unpack8(ldz(Z, t, 1024 + c0), cc); unpack8(ldz(Z, t, 2048 + c0), cx); unpack8(ldz(Z, t, 3072 + c0), rx);
#pragma unroll
    for (int e = 0; e < 8; ++e) { zc[e] = cc[e] * cx[e]; yc[e] = cb[e] * (cw[0][e] * z2[e] + cw[1][e] * z1[e] + cw[2][e] * zc[e]);
        xr[e] = rw[0][e] * r3[e] + rw[1][e] * r2[e] + rw[2][e] * r1[e] + rw[3][e] * rx[e] + rb[e]; }
    *(u32x4*)(Y0 + (size_t)t * 1024 + c0) = pack8(yc);
    *(u32x4*)(XR + (size_t)t * 1024 + c0) = pack8(xr);
    st8f(p.out + O_CZS + ((size_t)bs * 2 + 0) * 1024 + c0, z1); st8f(p.out + O_CZS + ((size_t)bs * 2 + 1) * 1024 + c0, zc);
    st8f(p.out + O_RCS + ((size_t)bs * 3 + 0) * 1024 + c0, r2); st8f(p.out + O_RCS + ((size_t)bs * 3 + 1) * 1024 + c0, r1); st8f(p.out + O_RCS + ((size_t)bs * 3 + 2) * 1024 + c0, rx);
}

__device__ void p2_attn_prompt(const Params& p, int item) {
    const bf16_t* Z = (const bf16_t*)(p.ws + W_Z); const bf16_t* MKB = (const bf16_t*)(p.ws + W_MKB); const bf16_t* VTB = (const bf16_t*)(p.ws + W_VTB);
    bf16_t* Y2 = (bf16_t*)(p.ws + W_YCAT) + (size_t)2 * TPAD * 1024;
    const int b = item >> 6, h = (item >> 4) & 3, qt = item & 15;
    const int w = threadIdx.x >> 6, lane = threadIdx.x & 63, fr = lane & 15, fq = lane >> 4;
    const int t = b * 2048 + qt * 128 + w * 16 + fr;
    bf16x8 qf[8];
#pragma unroll
    for (int ks = 0; ks < 8; ++ks) qf[ks] = *(const bf16x8*)(Z + (size_t)t * INW + 5120 + h * 256 + ks * 32 + fq * 8);
    f32x4 sacc[16];
#pragma unroll
    for (int nb = 0; nb < 16; ++nb) {
        sacc[nb] = (f32x4){0.f, 0.f, 0.f, 0.f};
        const bf16_t* kp = MKB + (size_t)(b * 256 + nb * 16 + fr) * 1024 + h * 256 + fq * 8;
#pragma unroll
        for (int ks = 0; ks < 8; ++ks) { const bf16x8 kf = *(const bf16x8*)(kp + ks * 32); sacc[nb] = __builtin_amdgcn_mfma_f32_16x16x32_bf16(kf, qf[ks], sacc[nb], 0, 0, 0); }
    }
    float mx = -3.0e38f;
#pragma unroll
    for (int nb = 0; nb < 16; ++nb)
#pragma unroll
        for (int j = 0; j < 4; ++j) { sacc[nb][j] *= 0.0625f; mx = fmaxf(mx, sacc[nb][j]); }
    mx = fmaxf(mx, __shfl_xor(mx, 16, 64)); mx = fmaxf(mx, __shfl_xor(mx, 32, 64));
    float sum = 0.f;
#pragma unroll
    for (int nb = 0; nb < 16; ++nb)
#pragma unroll
        for (int j = 0; j < 4; ++j) { sacc[nb][j] = fast_exp(sacc[nb][j] - mx); sum += sacc[nb][j]; }
    sum += __shfl_xor(sum, 16, 64); sum += __shfl_xor(sum, 32, 64);
    const float inv = 1.0f / sum;
    bf16x8 pf[8];
#pragma unroll
    for (int s2 = 0; s2 < 8; ++s2) {
        u32x4 w4; w4.x = cvt_pk_bf16(sacc[2 * s2][0] * inv, sacc[2 * s2][1] * inv); w4.y = cvt_pk_bf16(sacc[2 * s2][2] * inv, sacc[2 * s2][3] * inv);
        w4.z = cvt_pk_bf16(sacc[2 * s2 + 1][0] * inv, sacc[2 * s2 + 1][1] * inv); w4.w = cvt_pk_bf16(sacc[2 * s2 + 1][2] * inv, sacc[2 * s2 + 1][3] * inv);
        pf[s2] = __builtin_bit_cast(bf16x8, w4);
    }
#pragma unroll 4
    for (int db = 0; db < 16; ++db) {
        f32x4 o = (f32x4){0.f, 0.f, 0.f, 0.f};
        const bf16_t* vp = VTB + ((size_t)b * 1024 + h * 256 + db * 16 + fr) * 256 + fq * 4;
#pragma unroll
        for (int s2 = 0; s2 < 8; ++s2) { const u32x2 v0 = *(const u32x2*)(vp + s2 * 32), v1 = *(const u32x2*)(vp + s2 * 32 + 16);
            u32x4 vv; vv.x = v0.x; vv.y = v0.y; vv.z = v1.x; vv.w = v1.y;
            o = __builtin_amdgcn_mfma_f32_16x16x32_bf16(__builtin_bit_cast(bf16x8, vv), pf[s2], o, 0, 0, 0); }
        u32x2 ow; ow.x = cvt_pk_bf16(o[0], o[1]); ow.y = cvt_pk_bf16(o[2], o[3]);
        *(u32x2*)(Y2 + (size_t)t * 1024 + h * 256 + db * 16 + fq * 4) = ow;
    }
}

__device__ void p2_attn_sample(const Params& p, int pair, float* lds) {
    const int TIDX = launder_tid();
    const bf16_t* Z = (const bf16_t*)(p.ws + W_Z); bf16_t* Y2 = (bf16_t*)(p.ws + W_YCAT) + (size_t)2 * TPAD * 1024;
    const int w = TIDX >> 6, lane = TIDX & 63, kq = lane >> 4, dl = lane & 15;
    const int b = pair >> 2, h = pair & 3;
    f32x4 qv[4];
#pragma unroll
    for (int j = 0; j < 4; ++j) { const u32x2 qw = *(const u32x2*)(Z + (size_t)(TP + b) * INW + 5120 + h * 256 + dl * 4 + 64 * j);
        qv[j] = (f32x4){bf_lo(qw.x), bf_hi(qw.x), bf_lo(qw.y), bf_hi(qw.y)} * 0.0625f; }
    const float* Kc = p.in[3]; const float* Vc = p.in[4];
    float sc[8];
#pragma unroll
    for (int i = 0; i < 8; ++i) {
        const int key = w * 32 + 4 * i + kq; const float* kp = Kc + (((size_t)b * 256 + key) * 4 + h) * 256 + dl * 4;
        float d = 0.f;
#pragma unroll
        for (int j = 0; j < 4; ++j) { const f32x4 kv = *(const f32x4*)(kp + 64 * j); d += kv[0] * qv[j][0] + kv[1] * qv[j][1] + kv[2] * qv[j][2] + kv[3] * qv[j][3]; }
        d += __shfl_xor(d, 1, 64); d += __shfl_xor(d, 2, 64); d += __shfl_xor(d, 4, 64); d += __shfl_xor(d, 8, 64);
        sc[i] = d;
    }
    float mx = sc[0];
#pragma unroll
    for (int i = 1; i < 8; ++i) mx = fmaxf(mx, sc[i]);
    mx = fmaxf(mx, __shfl_xor(mx, 16, 64)); mx = fmaxf(mx, __shfl_xor(mx, 32, 64));
    float l = 0.f; f32x4 o[4];
#pragma unroll
    for (int j = 0; j < 4; ++j) o[j] = (f32x4){0.f, 0.f, 0.f, 0.f};
#pragma unroll
    for (int i = 0; i < 8; ++i) {
        const float pe = fast_exp(sc[i] - mx); l += pe;
        const int key = w * 32 + 4 * i + kq; const float* vp = Vc + (((size_t)b * 256 + key) * 4 + h) * 256 + dl * 4;
#pragma unroll
        for (int j = 0; j < 4; ++j) { const f32x4 vv = *(const f32x4*)(vp + 64 * j); o[j] += vv * pe; }
    }
    l += __shfl_xor(l, 16, 64); l += __shfl_xor(l, 32, 64);
#pragma unroll
    for (int j = 0; j < 4; ++j)
#pragma unroll
        for (int e = 0; e < 4; ++e) { float v = o[j][e]; v += __shfl_xor(v, 16, 64); v += __shfl_xor(v, 32, 64); o[j][e] = v; }
    float* my = lds + w * 260;
    if (kq == 0) {
#pragma unroll
        for (int j = 0; j < 4; ++j) *(f32x4*)(my + dl * 4 + 64 * j) = o[j];
        if (dl == 0) { my[256] = mx; my[257] = l; }
    }
    __syncthreads();
    if (TIDX < 256) {
        const int d = TIDX; float M = lds[256];
#pragma unroll
        for (int ww = 1; ww < 8; ++ww) M = fmaxf(M, lds[ww * 260 + 256]);
        float L = 0.f, v = 0.f;
#pragma unroll
        for (int ww = 0; ww < 8; ++ww) { const float e = fast_exp(lds[ww * 260 + 256] - M); L += e * lds[ww * 260 + 257]; v += e * lds[ww * 260 + d]; }
        Y2[(size_t)(TP + b) * 1024 + h * 256 + d] = f2bf(v / L);
    }
    __syncthreads();
}

template <int NB>
__device__ __forceinline__ void skinny_acc(f32x4 (&acc)[NB], const bf16_t* __restrict__ Arow, const bf16_t* __restrict__ Brow, size_t nbstride, int K) {
    bf16x8 a0[4], b0[NB][4], a1[4], b1[NB][4];
#define SK_LOAD(a, b, kk) do { _Pragma("unroll") for (int s2 = 0; s2 < 4; ++s2) { a[s2] = *(const bf16x8*)(Arow + (kk) + s2 * 32); \
        _Pragma("unroll") for (int nb = 0; nb < NB; ++nb) b[nb][s2] = *(const bf16x8*)(Brow + nb * nbstride + (kk) + s2 * 32); } } while (0)
#define SK_MMA(a, b) do { _Pragma("unroll") for (int s2 = 0; s2 < 4; ++s2) _Pragma("unroll") for (int nb = 0; nb < NB; ++nb) acc[nb] = __builtin_amdgcn_mfma_f32_16x16x32_bf16(b[nb][s2], a[s2], acc[nb], 0, 0, 0); } while (0)
    SK_LOAD(a0, b0, 0);
#pragma unroll 1
    for (int k0 = 0; k0 < K; k0 += 256) {
        SK_LOAD(a1, b1, k0 + 128);
        SK_MMA(a0, b0);
        if (k0 + 256 < K) SK_LOAD(a0, b0, k0 + 256);
        SK_MMA(a1, b1);
    }
#undef SK_LOAD
#undef SK_MMA
}

template <int NB, int KB>
__device__ __forceinline__ void skinny_k(f32x4 (&acc)[NB][8], const bf16_t* __restrict__ A0, int lda, const bf16_t* __restrict__ B0, size_t nbstride, int ksteps) {
#pragma unroll 1
    for (int ks = 0; ks < ksteps; ks += KB) {
        bf16x8 a[KB][8], b[KB][NB];
#pragma unroll
        for (int s2 = 0; s2 < KB; ++s2) {
#pragma unroll
            for (int rb = 0; rb < 8; ++rb) a[s2][rb] = *(const bf16x8*)(A0 + (size_t)rb * 16 * lda + (ks + s2) * 32);
#pragma unroll
            for (int nb = 0; nb < NB; ++nb) b[s2][nb] = *(const bf16x8*)(B0 + nb * nbstride + (ks + s2) * 32); }
#pragma unroll
        for (int s2 = 0; s2 < KB; ++s2)
#pragma unroll
            for (int nb = 0; nb < NB; ++nb)
#pragma unroll
                for (int rb = 0; rb < 8; ++rb) acc[nb][rb] = __builtin_amdgcn_mfma_f32_16x16x32_bf16(b[s2][nb], a[s2][rb], acc[nb][rb], 0, 0, 0);
    }
}
__device__ __forceinline__ f32x4 xwave_reduce(float* lds, const f32x4 (&acc)[8], int w, int lane) {
    __syncthreads();
#pragma unroll
    for (int rb = 0; rb < 8; ++rb) *(f32x4*)(lds + ((w * 8 + rb) * 64 + lane) * 4) = acc[rb];
    __syncthreads();
    f32x4 v = *(const f32x4*)(lds + ((0 * 8 + w) * 64 + lane) * 4);
#pragma unroll
    for (int w2 = 1; w2 < 8; ++w2) v += *(const f32x4*)(lds + ((w2 * 8 + w) * 64 + lane) * 4);
    return v;
}
__device__ void s1_zin(const Params& p, int ti, float* lds) {
    const int w = threadIdx.x >> 6, lane = threadIdx.x & 63, fr = lane & 15, fq = lane >> 4, n0 = ti * 48, kw0 = w * 256;
    const bf16_t* A0 = (const bf16_t*)(p.ws + W_AALL) + (size_t)(TP + fr) * DM + fq * 8 + kw0; const bf16_t* B0 = (const bf16_t*)(p.ws + W_BTALL) + (size_t)(n0 + fr) * DM + fq * 8 + kw0;
    f32x4 acc[3][8];
#pragma unroll
    for (int nb = 0; nb < 3; ++nb)
#pragma unroll
        for (int rb = 0; rb < 8; ++rb) acc[nb][rb] = (f32x4){0.f, 0.f, 0.f, 0.f};
    skinny_k<3, 2>(acc, A0, DM, B0, (size_t)16 * DM, 8);
    bf16_t* Z = (bf16_t*)(p.ws + W_Z); const int row = TP + 16 * w + fr;
#pragma unroll
    for (int nb = 0; nb < 3; ++nb) { const f32x4 v = xwave_reduce(lds, acc[nb], w, lane);
        u32x2 o; o.x = cvt_pk_bf16(v[0], v[1]); o.y = cvt_pk_bf16(v[2], v[3]); *(u32x2*)(Z + (size_t)row * INW + n0 + nb * 16 + 4 * fq) = o; }
}
__device__ void s3_gates(const Params& p, int ti) {
    const int w = threadIdx.x >> 6, lane = threadIdx.x & 63, fr = lane & 15, fq = lane >> 4, row = TP + 16 * w + fr, h = ti >> 3, nb = ti & 7;
    const bf16_t* XR = (const bf16_t*)(p.ws + W_XR);
    const bf16_t* A = XR + (size_t)row * 1024 + (h & ~1) * 128 + fq * 8; const bf16_t* B = (const bf16_t*)(p.ws + W_WGT) + (size_t)(h * 256 + nb * 16 + fr) * 256 + fq * 8;
    f32x4 acc[2] = {{0.f, 0.f, 0.f, 0.f}, {0.f, 0.f, 0.f, 0.f}};
    skinny_acc<2>(acc, A, B, (size_t)128 * 256, 256);
    const int ch = h * 128 + nb * 16 + 4 * fq;
    const f32x4 vba = *(const f32x4*)(p.in[13] + ch), vbx = *(const f32x4*)(p.in[15] + ch), l = *(const f32x4*)(p.in[16] + ch);
    const u32x2 xw = *(const u32x2*)(XR + (size_t)row * 1024 + ch); const float xr[4] = {bf_lo(xw.x), bf_hi(xw.x), bf_lo(xw.y), bf_hi(xw.y)}; f32x4 av, uv;
#pragma unroll
    for (int j = 0; j < 4; ++j) { const float ex = fast_exp(-l[j]); const float sp = ex < 0.03f ? ex * (1.0f + ex * (-0.5f + ex * (0.33333333f - 0.25f * ex))) : __logf(1.0f + ex);
        const float r = sigmoidf_(acc[0][j] + vba[j]), ig = sigmoidf_(acc[1][j] + vbx[j]); const float la = -8.0f * sp * r;
        av[j] = fast_exp(la); uv[j] = __builtin_amdgcn_sqrtf(fmaxf(1.0f - av[j] * av[j], 0.f)) * ig * xr[j]; }
    *(f32x4*)((float*)(p.ws + W_SA) + (size_t)row * 1024 + ch) = av; *(f32x4*)((float*)(p.ws + W_SU) + (size_t)row * 1024 + ch) = uv;
}
__device__ void s5_merge(const Params& p, int ti, float* lds) {
    const int w = threadIdx.x >> 6, lane = threadIdx.x & 63, fr = lane & 15, fq = lane >> 4, n0 = ti * 16, col = n0 + 4 * fq, kw0 = w * 128;
    const bf16_t* Z = (const bf16_t*)(p.ws + W_Z);
    f32x4 m[8];
#pragma unroll
    for (int rb = 0; rb < 8; ++rb) m[rb] = (f32x4){0.f, 0.f, 0.f, 0.f};
#pragma unroll 1
    for (int j = 0; j < 3; ++j) {
        const bf16_t* A0 = (const bf16_t*)(p.ws + W_YCAT) + ((size_t)j * TPAD + TP + fr) * 1024 + fq * 8 + kw0; const bf16_t* B0 = (const bf16_t*)(p.ws + W_WBRT) + ((size_t)j * 2048 + n0 + fr) * 1024 + fq * 8 + kw0;
        f32x4 acc[1][8];
#pragma unroll
        for (int rb = 0; rb < 8; ++rb) acc[0][rb] = (f32x4){0.f, 0.f, 0.f, 0.f};
        u32x2 gw[8];
#pragma unroll
        for (int rb = 0; rb < 8; ++rb) gw[rb] = *(const u32x2*)(Z + (size_t)(TP + rb * 16 + fr) * INW + 6144 + j * 2048 + col);
        skinny_k<1, 4>(acc, A0, 1024, B0, 0, 4);
#pragma unroll
        for (int rb = 0; rb < 8; ++rb) { m[rb][0] += sigmoidf_(bf_lo(gw[rb].x)) * acc[0][rb][0]; m[rb][1] += sigmoidf_(bf_hi(gw[rb].x)) * acc[0][rb][1];
            m[rb][2] += sigmoidf_(bf_lo(gw[rb].y)) * acc[0][rb][2]; m[rb][3] += sigmoidf_(bf_hi(gw[rb].y)) * acc[0][rb][3]; }
    }
    const f32x4 v = xwave_reduce(lds, m, w, lane);
    u32x2 o; o.x = cvt_pk_bf16(v[0], v[1]); o.y = cvt_pk_bf16(v[2], v[3]); *(u32x2*)((bf16_t*)(p.ws + W_MB) + (size_t)(TP + 16 * w + fr) * DM + col) = o;
}
__device__ void s68_plain(const Params& p, int ti, size_t wA, size_t wB, float* outF, bf16_t* outB, float* lds) {
    const int w = threadIdx.x >> 6, lane = threadIdx.x & 63, fr = lane & 15, fq = lane >> 4, n0 = ti * 16, col = n0 + 4 * fq, kw0 = w * 256;
    const bf16_t* A0 = (const bf16_t*)(p.ws + wA) + (size_t)(TP + fr) * DM + fq * 8 + kw0; const bf16_t* B0 = (const bf16_t*)(p.ws + wB) + (size_t)(n0 + fr) * DM + fq * 8 + kw0;
    f32x4 acc[1][8];
#pragma unroll
    for (int rb = 0; rb < 8; ++rb) acc[0][rb] = (f32x4){0.f, 0.f, 0.f, 0.f};
    skinny_k<1, 4>(acc, A0, DM, B0, 0, 8);
    const f32x4 v = xwave_reduce(lds, acc[0], w, lane); const int row = TP + 16 * w + fr;
    if (outF) *(f32x4*)(outF + (size_t)row * DM + col) = v;
    else { u32x2 o; o.x = cvt_pk_bf16(v[0], v[1]); o.y = cvt_pk_bf16(v[2], v[3]); *(u32x2*)(outB + (size_t)row * DM + col) = o; }
}
__device__ void s9_scores(const Params& p, int ti) {
    const int w = threadIdx.x >> 6, lane = threadIdx.x & 63, fr = lane & 15, fq = lane >> 4, row = TP + 16 * w + fr, h = ti >> 3, nbp = ti & 7;
    const bf16_t* A = (const bf16_t*)(p.ws + W_QP) + (size_t)row * DM + h * 256 + fq * 8; const bf16_t* B = (const bf16_t*)(p.ws + W_WKT) + (size_t)(h * 256 + nbp * 32 + fr) * 256 + fq * 8;
    f32x4 acc[2] = {{0.f, 0.f, 0.f, 0.f}, {0.f, 0.f, 0.f, 0.f}};
    skinny_acc<2>(acc, A, B, (size_t)16 * 256, 256);
    float* SC = (float*)(p.ws + W_SC) + (size_t)row * DM + h * 256 + nbp * 32 + 4 * fq;
    *(f32x4*)SC = acc[0]; *(f32x4*)(SC + 16) = acc[1];
}

__device__ void p4a(const Params& p) {
    const float* SA = (const float*)(p.ws + W_SA); const float* SU = (const float*)(p.ws + W_SU); float* CA = (float*)(p.ws + W_CHK); float* CH = CA + 4 * 32 * 1024;
    for (int idx = blockIdx.x * 512 + threadIdx.x; idx < 4 * 32 * 1024; idx += gridDim.x * 512) {
        const int ch = idx & 1023, chunk = (idx >> 10) & 31, b = idx >> 15; const size_t base = ((size_t)b * 2048 + chunk * 64) * 1024 + ch;
        float A = 1.f, H = 0.f;
#pragma unroll 8
        for (int s = 0; s < 64; ++s) { const float a = SA[base + (size_t)s * 1024], u = SU[base + (size_t)s * 1024]; H = a * H + u; A *= a; }
        CA[idx] = A; CH[idx] = H;
    }
}
__device__ void p4b(const Params& p) {
    const float* __restrict__ SA = (const float*)(p.ws + W_SA); const float* __restrict__ SU = (const float*)(p.ws + W_SU); const float* __restrict__ CA = (const float*)(p.ws + W_CHK); const float* __restrict__ CH = CA + 4 * 32 * 1024;
    const bf16_t* __restrict__ Z = (const bf16_t*)(p.ws + W_Z); bf16_t* __restrict__ Y1 = (bf16_t*)(p.ws + W_YCAT) + (size_t)TPAD * 1024;
    const int nprompt = 4 * 32 * 1024, ntot = nprompt + TS * 1024;
    for (int idx = blockIdx.x * 512 + threadIdx.x; idx < ntot; idx += gridDim.x * 512) {
        if (idx < nprompt) {
            const int ch = idx & 1023, chunk = (idx >> 10) & 31, b = idx >> 15;
            float h = 0.f;
#pragma unroll 1
            for (int j0 = 0; j0 < chunk; j0 += 8) {
                float ca[8], chh[8];
#pragma unroll
                for (int e = 0; e < 8; ++e) { const int jj = min(j0 + e, 31), q = ((b * 32 + jj) << 10) + ch; ca[e] = CA[q]; chh[e] = CH[q]; }
#pragma unroll
                for (int e = 0; e < 8; ++e) if (j0 + e < chunk) h = ca[e] * h + chh[e];
            }
            const size_t t0 = (size_t)b * 2048 + chunk * 64;
#pragma unroll 1
            for (int s0 = 0; s0 < 64; s0 += 16) {
                float a[16], u[16], rg[16];
#pragma unroll
                for (int s = 0; s < 16; ++s) { const size_t t = t0 + s0 + s; a[s] = SA[t * 1024 + ch]; u[s] = SU[t * 1024 + ch]; rg[s] = bf1(Z[t * INW + 4096 + ch]); }
#pragma unroll
                for (int s = 0; s < 16; ++s) { h = a[s] * h + u[s]; Y1[(t0 + s0 + s) * 1024 + ch] = f2bf(h * gelu_tanh(rg[s])); }
            }
            if (chunk == 31) p.out[O_HP + (size_t)b * 1024 + ch] = h;
        } else {
            const int j = idx - nprompt, ch = j & 1023, bs = j >> 10; const size_t t = TP + bs;
            const float h = SA[t * 1024 + ch] * p.in[7][(size_t)bs * 1024 + ch] + SU[t * 1024 + ch];
            p.out[O_HS + (size_t)bs * 1024 + ch] = h;
            const float rg = bf1(Z[t * INW + 4096 + ch]); Y1[t * 1024 + ch] = f2bf(h * gelu_tanh(rg));
        }
    }
}


__device__ void p4a_tile(const Params& p, int pm, int h) {
    const float* SA = (const float*)(p.ws + W_SA); const float* SU = (const float*)(p.ws + W_SU); float* CA = (float*)(p.ws + W_CHK); float* CH = CA + 4 * 32 * 1024;
    const int ch = h * 128 + (threadIdx.x & 127), row0 = pm * 256 + (threadIdx.x >> 7) * 64, b = row0 >> 11, chunk = (row0 & 2047) >> 6;
    const size_t base = (size_t)row0 * 1024 + ch;
    float A = 1.f, H = 0.f;
#pragma unroll 1
    for (int s0 = 0; s0 < 64; s0 += 16) { float a[16], u[16];
#pragma unroll
        for (int s2 = 0; s2 < 16; ++s2) { a[s2] = SA[base + (size_t)(s0 + s2) * 1024]; u[s2] = SU[base + (size_t)(s0 + s2) * 1024]; }
#pragma unroll
        for (int s2 = 0; s2 < 16; ++s2) { H = a[s2] * H + u[s2]; A *= a[s2]; } }
    const int idx = ((b * 32 + chunk) << 10) + ch; CA[idx] = A; CH[idx] = H;
}
__device__ void s9_full(const Params& p, int h) {
    const int w = threadIdx.x >> 6, lane = threadIdx.x & 63, fr = lane & 15, fq = lane >> 4, row = TP + 16 * w + fr;
    const bf16_t* A = (const bf16_t*)(p.ws + W_QP) + (size_t)row * DM + h * 256 + fq * 8; float* SC = (float*)(p.ws + W_SC) + (size_t)row * DM + h * 256 + 4 * fq;
#pragma unroll 1
    for (int g4 = 0; g4 < 4; ++g4) {
        const bf16_t* B = (const bf16_t*)(p.ws + W_WKT) + (size_t)(h * 256 + g4 * 64 + fr) * 256 + fq * 8;
        f32x4 acc[4] = {{0.f, 0.f, 0.f, 0.f}, {0.f, 0.f, 0.f, 0.f}, {0.f, 0.f, 0.f, 0.f}, {0.f, 0.f, 0.f, 0.f}};
        skinny_acc<4>(acc, A, B, (size_t)16 * 256, 256);
#pragma unroll
        for (int nb = 0; nb < 4; ++nb) *(f32x4*)(SC + g4 * 64 + nb * 16) = acc[nb];
    }
}

__device__ void p7(const Params& p, float* lds) {
    const float* H1 = (const float*)(p.ws + W_H1); bf16_t* X1B = (bf16_t*)(p.ws + W_X1B);
    const int lane = threadIdx.x & 63, w = threadIdx.x >> 6, gw = blockIdx.x * 8 + w, nw = gridDim.x * 8;
    for (int row = gw; row < TP; row += nw) {
        f32x4 v[8]; float s = 0.f; const float* xrow = p.in[0] + (size_t)row * DM;
#pragma unroll
        for (int j = 0; j < 8; ++j) { v[j] = *(const f32x4*)(H1 + (size_t)row * DM + j * 256 + lane * 4) + *(const f32x4*)(xrow + j * 256 + lane * 4) * DN_ALPHA; s += v[j][0] + v[j][1] + v[j][2] + v[j][3]; }
        const float mean = wave_sum(s) * (1.0f / DM); float q = 0.f;
#pragma unroll
        for (int j = 0; j < 8; ++j) { v[j] -= mean; q += v[j][0] * v[j][0] + v[j][1] * v[j][1] + v[j][2] * v[j][2] + v[j][3] * v[j][3]; }
        const float rstd = rsqrtf(wave_sum(q) * (1.0f / DM) + LN_EPS);
#pragma unroll
        for (int j = 0; j < 8; ++j) { const int c = j * 256 + lane * 4; const f32x4 g = *(const f32x4*)(p.in[23] + c), bb = *(const f32x4*)(p.in[24] + c);
            const f32x4 y = v[j] * rstd * g + bb;
            u32x2 wd; wd.x = cvt_pk_bf16(y[0], y[1]); wd.y = cvt_pk_bf16(y[2], y[3]); *(u32x2*)(X1B + (size_t)row * DM + c) = wd; }
    }
    for (int r = blockIdx.x; r < TS; r += gridDim.x) {
        const int row = TP + r, c = w * 256 + lane * 4;
        f32x4 v = *(const f32x4*)(H1 + (size_t)row * DM + c) + *(const f32x4*)(p.in[1] + (size_t)r * DM + c) * DN_ALPHA;
        const float s = wave_sum(v[0] + v[1] + v[2] + v[3]);
        __syncthreads();
        if (lane == 0) lds[w] = s;
        __syncthreads();
        float tot = 0.f;
#pragma unroll
        for (int ww = 0; ww < 8; ++ww) tot += lds[ww];
        v -= tot * (1.0f / DM);
        const float q = wave_sum(v[0] * v[0] + v[1] * v[1] + v[2] * v[2] + v[3] * v[3]);
        if (lane == 0) lds[8 + w] = q;
        __syncthreads();
        float qt = 0.f;
#pragma unroll
        for (int ww = 0; ww < 8; ++ww) qt += lds[8 + ww];
        const float rstd = rsqrtf(qt * (1.0f / DM) + LN_EPS);
        const f32x4 g = *(const f32x4*)(p.in[23] + c), bb = *(const f32x4*)(p.in[24] + c); const f32x4 y = v * rstd * g + bb;
        u32x2 wd; wd.x = cvt_pk_bf16(y[0], y[1]); wd.y = cvt_pk_bf16(y[2], y[3]); *(u32x2*)(X1B + (size_t)row * DM + c) = wd;
    }
}

__device__ __forceinline__ unsigned ord_key(float f) { const unsigned u = __float_as_uint(f); return (u & 0x80000000u) ? ~u : (u | 0x80000000u); }
__device__ __forceinline__ float ord_val(unsigned k) { return __uint_as_float((k & 0x80000000u) ? (k & 0x7fffffffu) : ~k); }

#define CE_DESC(a, b) do { const unsigned mx_ = max(a, b), mn_ = min(a, b); a = mx_; b = mn_; } while (0)
__device__ void p9b(const Params& p, int mode) {
    const float* SC = (const float*)(p.ws + W_SC); u32x4* PICKS = (u32x4*)(p.ws + W_PICKS); const float* SCU = (const float*)(p.ws + W_SCU); const float* SCV = (const float*)(p.ws + W_SCV);
    const int nitem = TT * 16, gid = blockIdx.x * 512 + threadIdx.x, gth = gridDim.x * 512;
    int pm1 = 0, h1 = 0; if (mode == 1) std_tile((int)blockIdx.x, 32, 8, pm1, h1);
    const bool fast = (mode == 0 && gth == TP * 16);
    const int npass = (mode == 1 || fast) ? 2 : (nitem + gth - 1) / gth;
#pragma unroll 1
    for (int pass_ = 0; pass_ < npass; ++pass_) {
        int item = gid + pass_ * gth;
        if (mode == 1) { const int tt = pass_ == 0 ? pm1 * 256 + (int)(threadIdx.x >> 1) : TP + (int)(threadIdx.x >> 1), hh = pass_ == 0 ? h1 : (int)blockIdx.x;
            item = (pass_ == 0 || (blockIdx.x < 8 && threadIdx.x < 256)) ? ((tt * 8 + hh) << 1) + (int)(threadIdx.x & 1) : nitem; }
        if (fast && pass_ == 1) item = (threadIdx.x < 64 && blockIdx.x < 32) ? TP * 16 + (int)blockIdx.x * 64 + (int)threadIdx.x : nitem;
        if (item >= nitem) continue;
        const int c = item & 1, th = item >> 1, t = th >> 3, h = th & 7;
        const float* sp = SC + (size_t)t * DM + h * 256 + c * 128;
        unsigned key[128];
#pragma unroll
        for (int i = 0; i < 32; ++i) { const f32x4 v = *(const f32x4*)(sp + i * 4);
#pragma unroll
            for (int e = 0; e < 4; ++e) key[i * 4 + e] = (ord_key(v[e]) & 0xffffff80u) | (unsigned)(127 - (i * 4 + e)); }
#pragma unroll
        for (int gq = 0; gq < 8; ++gq)
#pragma unroll
            for (int k = 2; k <= 16; k <<= 1)
#pragma unroll
                for (int j = k >> 1; j > 0; j >>= 1)
#pragma unroll
                    for (int i = 0; i < 16; ++i) { const int l = i ^ j; if (l > i) { if ((i & k) == 0) CE_DESC(key[gq * 16 + i], key[gq * 16 + l]); else CE_DESC(key[gq * 16 + l], key[gq * 16 + i]); } }
#pragma unroll
        for (int span = 1; span < 8; span <<= 1)
#pragma unroll
            for (int gq = 0; gq < 8; gq += 2 * span) {
#pragma unroll
                for (int i = 0; i < 16; ++i) key[gq * 16 + i] = max(key[gq * 16 + i], key[(gq + span) * 16 + 15 - i]);
#pragma unroll
                for (int j = 8; j > 0; j >>= 1)
#pragma unroll
                    for (int i = 0; i < 16; ++i) { const int l = i ^ j; if (l > i) CE_DESC(key[gq * 16 + i], key[gq * 16 + l]); }
            }
        unsigned top[16];
#pragma unroll
        for (int q = 0; q < 16; ++q) top[q] = key[q];
        float sm[16], so[16]; int im[16], io[16];
#pragma unroll
        for (int q = 0; q < 16; ++q) { sm[q] = ord_val(top[q] & 0xffffff80u); im[q] = 127 - (int)(top[q] & 127u); so[q] = __shfl_xor(sm[q], 1, 64); io[q] = __shfl_xor(im[q], 1, 64); }
        float s1[16], s2[16]; int i1[16], i2[16];
#pragma unroll
        for (int q = 0; q < 16; ++q) { s1[q] = c ? so[q] : sm[q]; s2[q] = c ? sm[q] : so[q]; i1[q] = c ? io[q] : im[q]; i2[q] = c ? im[q] : io[q]; }
        unsigned ck[50]; int nc = 0;
#pragma unroll
        for (int i = 0; i < 16; ++i)
#pragma unroll
            for (int j = 0; j < 16; ++j) if ((i + 1) * (j + 1) <= 16) { ck[nc] = (ord_key(s1[i] + s2[j]) & 0xffffff00u) | (unsigned)(255 - (i * 16 + j)); ++nc; }
        unsigned c64[64];
#pragma unroll
        for (int i = 0; i < 64; ++i) c64[i] = (i < 50) ? ck[i] : 0u;
#pragma unroll
        for (int gq = 0; gq < 4; ++gq)
#pragma unroll
            for (int k = 2; k <= 16; k <<= 1)
#pragma unroll
                for (int j = k >> 1; j > 0; j >>= 1)
#pragma unroll
                    for (int i = 0; i < 16; ++i) { const int l = i ^ j; if (l > i) { if ((i & k) == 0) CE_DESC(c64[gq * 16 + i], c64[gq * 16 + l]); else CE_DESC(c64[gq * 16 + l], c64[gq * 16 + i]); } }
#pragma unroll
        for (int span = 1; span < 4; span <<= 1)
#pragma unroll
            for (int gq = 0; gq < 4; gq += 2 * span) {
#pragma unroll
                for (int i = 0; i < 16; ++i) c64[gq * 16 + i] = max(c64[gq * 16 + i], c64[(gq + span) * 16 + 15 - i]);
#pragma unroll
                for (int j = 8; j > 0; j >>= 1)
#pragma unroll
                    for (int i = 0; i < 16; ++i) { const int l = i ^ j; if (l > i) CE_DESC(c64[gq * 16 + i], c64[gq * 16 + l]); }
            }
        unsigned ct[16];
#pragma unroll
        for (int q = 0; q < 16; ++q) ct[q] = c64[q];
        const float vmax = ord_val(ct[0] & 0xffffff00u); float ev[16], esum = 0.f;
#pragma unroll
        for (int q = 0; q < 16; ++q) { ev[q] = fast_exp(ord_val(ct[q] & 0xffffff00u) - vmax); esum += ev[q]; }
        const float einv = 1.0f / esum;
#pragma unroll
        for (int q = 0; q < 8; ++q) {
            const unsigned cm = (unsigned)(-c);
            const unsigned kk = ct[2 * q] ^ ((ct[2 * q] ^ ct[2 * q + 1]) & cm);
            const unsigned eb0 = __float_as_uint(ev[2 * q]), eb1 = __float_as_uint(ev[2 * q + 1]);
            const float gwt = __uint_as_float(eb0 ^ ((eb0 ^ eb1) & cm)) * einv;
            const int cid = 255 - (int)(kk & 255u), ci = cid >> 4, cj = cid & 15;
            int e1 = 0, e2 = 0;
#pragma unroll
            for (int r = 0; r < 16; ++r) { e1 = (ci == r) ? i1[r] : e1; e2 = (cj == r) ? i2[r] : e2; }
            const int ex = e1 * 128 + e2;
            u32x4 pk; pk.x = (unsigned)ex; pk.y = __float_as_uint(gwt * SCV[ex]); pk.z = __float_as_uint(SCU[ex]); pk.w = 0u;
            PICKS[(size_t)t * 128 + h * 16 + 2 * q + c] = pk;
        }
    }
}

__device__ void p10(const Params& p, float* lds) {
    const bf16_t* X1B = (const bf16_t*)(p.ws + W_X1B); const u32x4* PICKS = (const u32x4*)(p.ws + W_PICKS);
    const unsigned char* U8 = p.ws + W_UB; const unsigned char* V8 = p.ws + W_UB + 2048;
    const int w = threadIdx.x >> 6, lane = threadIdx.x & 63;
    for (int t = blockIdx.x; t < TT; t += gridDim.x) {
        f32x2 xe[2][8];
#pragma unroll
        for (int j = 0; j < 2; ++j)
#pragma unroll
            for (int q = 0; q < 2; ++q) { const u32x4 v = *(const u32x4*)(X1B + (size_t)t * DM + j * 1024 + lane * 16 + q * 8);
                xe[j][4 * q] = (f32x2){bf_lo(v.x), bf_hi(v.x)}; xe[j][4 * q + 1] = (f32x2){bf_lo(v.y), bf_hi(v.y)}; xe[j][4 * q + 2] = (f32x2){bf_lo(v.z), bf_hi(v.z)}; xe[j][4 * q + 3] = (f32x2){bf_lo(v.w), bf_hi(v.w)}; }
        const u32x4 mypick = PICKS[(size_t)t * 128 + w * 16 + (lane & 15)];
        f32x2 y[2][8];
#pragma unroll
        for (int j = 0; j < 2; ++j)
#pragma unroll
            for (int e = 0; e < 8; ++e) y[j][e] = (f32x2){0.f, 0.f};
#pragma unroll 1
        for (int k = 0; k < 16; k += 8) {
            u32x4 uw[8][2], vw[8][2]; float cvv[8], suu[8];
#pragma unroll
            for (int g = 0; g < 8; ++g) {
                const unsigned e = (unsigned)__builtin_amdgcn_readlane((int)mypick.x, k + g) & 16383u;
                cvv[g] = __uint_as_float((unsigned)__builtin_amdgcn_readlane((int)mypick.y, k + g)); suu[g] = __uint_as_float((unsigned)__builtin_amdgcn_readlane((int)mypick.z, k + g));
                const unsigned char* up = U8 + (size_t)e * 4096 + lane * 16; const unsigned char* vp = V8 + (size_t)e * 4096 + lane * 16;
                uw[g][0] = *(const u32x4*)up; uw[g][1] = *(const u32x4*)(up + 1024); vw[g][0] = *(const u32x4*)vp; vw[g][1] = *(const u32x4*)(vp + 1024);
            }
#pragma unroll
            for (int g = 0; g < 8; ++g) {
                f32x2 d2 = (f32x2){0.f, 0.f};
#pragma unroll
                for (int j = 0; j < 2; ++j)
#pragma unroll
                    for (int q = 0; q < 4; ++q) { const int wd = (int)uw[g][j][q];
                        d2 += __builtin_amdgcn_cvt_pk_f32_fp8(wd, false) * xe[j][2 * q]; d2 += __builtin_amdgcn_cvt_pk_f32_fp8(wd, true) * xe[j][2 * q + 1]; }
                const float d = wave_sum(d2[0] + d2[1]);
                const float cf = cvv[g] * gelu_tanh(d * suu[g]);
#pragma unroll
                for (int j = 0; j < 2; ++j)
#pragma unroll
                    for (int q = 0; q < 4; ++q) { const int wd = (int)vw[g][j][q];
                        y[j][2 * q] += __builtin_amdgcn_cvt_pk_f32_fp8(wd, false) * cf; y[j][2 * q + 1] += __builtin_amdgcn_cvt_pk_f32_fp8(wd, true) * cf; }
            }
        }
#pragma unroll
        for (int j = 0; j < 2; ++j)
#pragma unroll
            for (int q = 0; q < 4; ++q) *(f32x4*)(lds + w * 2048 + j * 1024 + lane * 16 + q * 4) = (f32x4){y[j][2 * q][0], y[j][2 * q][1], y[j][2 * q + 1][0], y[j][2 * q + 1][1]};
        __syncthreads();
        {
            const int c0 = threadIdx.x * 4; f32x4 acc = *(const f32x4*)(lds + c0);
#pragma unroll
            for (int ww = 1; ww < 8; ++ww) acc += *(const f32x4*)(lds + ww * 2048 + c0);
            const u32x2 xw = *(const u32x2*)(X1B + (size_t)t * DM + c0); const f32x4 xv = (f32x4){bf_lo(xw.x), bf_hi(xw.x), bf_lo(xw.y), bf_hi(xw.y)};
            f32x4 r = xv * DN_ALPHA + acc;
            float s = wave_sum(r[0] + r[1] + r[2] + r[3]);
            if (lane == 0) lds[16384 + w] = s;
            __syncthreads();
            float tot = 0.f;
#pragma unroll
            for (int ww = 0; ww < 8; ++ww) tot += lds[16384 + ww];
            const float mean = tot * (1.0f / DM); r -= mean;
            float q = wave_sum(r[0] * r[0] + r[1] * r[1] + r[2] * r[2] + r[3] * r[3]);
            if (lane == 0) lds[16400 + w] = q;
            __syncthreads();
            float qt = 0.f;
#pragma unroll
            for (int ww = 0; ww < 8; ++ww) qt += lds[16400 + ww];
            const float rstd = rsqrtf(qt * (1.0f / DM) + LN_EPS);
            const f32x4 g = *(const f32x4*)(p.in[29] + c0), bb = *(const f32x4*)(p.in[30] + c0);
            *(f32x4*)(p.out + O_Y + (size_t)t * DM + c0) = r * rstd * g + bb;
        }
        __syncthreads();
    }
}


#ifdef DBG_DUMP
__device__ void dbg_dump(const Params& p) {
    const bf16_t* src = (const bf16_t*)(p.ws + DBG_DUMP_OFF);
    for (size_t i = (size_t)blockIdx.x * 512 + threadIdx.x; i < (size_t)TT * 1024; i += (size_t)gridDim.x * 512) {
        if (DBG_LAST <= 2 && i < 19947520 - O_CZP) p.out[O_CZP + i] = 0.f;
        const size_t r = i >> 10, c = i & 1023; p.out[O_Y + r * DM + c] = (r < TP) ? bf1(src[r * DBG_DUMP_LD + c]) : 0.f; p.out[O_Y + r * DM + 1024 + c] = 0.f; }
}
#endif

__device__ __forceinline__ void grid_bar(unsigned* words, unsigned n) {
    asm volatile("s_waitcnt vmcnt(0) lgkmcnt(0)" ::: "memory");
    __syncthreads();
    if (threadIdx.x == 0) {
        const unsigned G = gridDim.x, grp = blockIdx.x & 7u, gs = (G - grp + 7u) >> 3, ngrp = G < 8u ? G : 8u;
        __builtin_amdgcn_fence(__ATOMIC_RELEASE, "agent");
        const unsigned old = __hip_atomic_fetch_add(words + 32 * (1 + grp), 1u, __ATOMIC_RELAXED, __HIP_MEMORY_SCOPE_AGENT);
        if (old + 1u == n * gs) __hip_atomic_fetch_add(words, 1u, __ATOMIC_RELAXED, __HIP_MEMORY_SCOPE_AGENT);
        while (__hip_atomic_load(words, __ATOMIC_RELAXED, __HIP_MEMORY_SCOPE_AGENT) < n * ngrp) __builtin_amdgcn_s_sleep(1);
        __builtin_amdgcn_fence(__ATOMIC_ACQUIRE, "agent");
        asm volatile("s_waitcnt vmcnt(0)" ::: "memory");
    }
    __syncthreads();
}
extern __shared__ __attribute__((aligned(16))) unsigned char smem_raw[];

__global__ void __launch_bounds__(512, 2) fwd_kernel(Params p) {
    LAS unsigned char* lds = (LAS unsigned char*)smem_raw;
    float* ldsf = (float*)smem_raw;
    unsigned char* ws = p.ws;
    const int G = gridDim.x, c = blockIdx.x;
#ifndef ONLY_PH
#define ONLY_PH -1
#endif
    unsigned* barw = (unsigned*)(ws + W_BAR); unsigned nbar = 0;
#define UCONV(R0, R1) if (c >= G / 2) cvt_fp8_rows(p.in[27] + (size_t)(R0) * 2048, ws + W_UB + (size_t)(R0) * 4096, (float*)(ws + W_SCU) + (R0), (R1) - (R0), (c - G / 2) * 8 + (int)(threadIdx.x >> 6), (G - G / 2) * 8)
#define RUNPH_NB(n, ...) if ((ONLY_PH < 0 || ONLY_PH == (n)) && p.ph_lo <= (n) && (n) < p.ph_hi) { __VA_ARGS__; }
#define RUNPH(n, ...) if ((ONLY_PH < 0 || ONLY_PH == (n)) && p.ph_lo <= (n) && (n) < p.ph_hi) { __VA_ARGS__; if ((n) + 1 < p.ph_hi) { ++nbar; grid_bar(barw, nbar); } }
    RUNPH(0, phase0(p, ldsf))
    RUNPH(1, { Gemm g{(const bf16_t*)(ws + W_AALL), (const bf16_t*)(ws + W_BTALL), 2048, 2048, 2048};
            Epi1 e{(bf16_t*)(ws + W_Z), p.out + O_MK, p.out + O_MV, (bf16_t*)(ws + W_MKB), (bf16_t*)(ws + W_VTB)};
            SchedGrid s{32, 48, G, c, 0}; gemm_phase(lds, g, s, e);
            for (int ti = c; ti < 256; ti += G) s1_zin(p, ti, ldsf); })
    RUNPH(2, { const int nmk = G > 64 ? 32 : 0;
            if (c < nmk || nmk == 0) { Gemm g{(const bf16_t*)(ws + W_AALL), (const bf16_t*)(ws + W_BTALL), 2048, 2048, 2048};
                Epi1 e{(bf16_t*)(ws + W_Z), p.out + O_MK, p.out + O_MV, (bf16_t*)(ws + W_MKB), (bf16_t*)(ws + W_VTB)};
                SchedMKV s{nmk ? nmk : G, c}; gemm_phase(lds, g, s, e); }
            if (c >= nmk) for (int it = c - nmk; it < 672; it += G - nmk) {
                if (it < 512) p2_attn_sample(p, it, ldsf);
                else if (it < 640) p2_elem_prompt(p, it - 512);
                else p2_elem_sample(p, it - 640);
            }
            if (c >= nmk) cvt_fp8_rows(p.in[28], ws + W_UB + 2048, (float*)(ws + W_SCV), 16384, (c - nmk) * 8 + (int)(threadIdx.x >> 6), (G - nmk) * 8); })
    RUNPH(3, { Gemm g{(const bf16_t*)(ws + W_XR), (const bf16_t*)(ws + W_WGT), 1024, 256, 256};
            Epi3 e{(const bf16_t*)(ws + W_XR), (float*)(ws + W_SA), (float*)(ws + W_SU), p.in[13], p.in[15], p.in[16]};
            SchedGrid s{32, 8, G, c, 1}; gemm_phase(lds, g, s, e);
            for (int ti = c; ti < 64; ti += G) s3_gates(p, ti);
            if (G == 256) { int pm_, pn_; std_tile(c, 32, 8, pm_, pn_); asm volatile("s_waitcnt vmcnt(0)" ::: "memory"); __syncthreads(); p4a_tile(p, pm_, pn_); }
            for (int it = c; it < 256; it += G) { const int itx = (G == 256) ? (((it & 7) * 2 + (it >> 7)) << 4) + ((it >> 3) & 15) : it; p2_attn_prompt(p, itx); } })
    if (G != 256) { RUNPH(4, p4a(p)) }
    RUNPH(5, p4b(p))
    RUNPH(6, { Gemm g{(const bf16_t*)(ws + W_YCAT), (const bf16_t*)(ws + W_WBRT), 1024, 1024, 1024};
            Epi5 e{(const bf16_t*)(ws + W_Z), (bf16_t*)(ws + W_MF), (bf16_t*)(ws + W_MF) + (size_t)TPAD * DM, (bf16_t*)(ws + W_MB)};
            Sched5 s{G, c}; gemm_phase(lds, g, s, e);
            for (int ti = c; ti < 128; ti += G) s5_merge(p, ti, ldsf);
            UCONV(0, 5461); })
    RUNPH(7, { Gemm g{(const bf16_t*)(ws + W_MB), (const bf16_t*)(ws + W_WOT), 2048, 2048, 2048};
            EpiF e{(float*)(ws + W_H1), 2048};
            SchedGrid s{32, 8, G, c, 0}; gemm_phase(lds, g, s, e);
            for (int ti = c; ti < 128; ti += G) s68_plain(p, ti, W_MB, W_WOT, (float*)(ws + W_H1), nullptr, ldsf);
            UCONV(5461, 10922); })
    RUNPH(8, p7(p, ldsf))
    RUNPH(9, { Gemm g{(const bf16_t*)(ws + W_X1B), (const bf16_t*)(ws + W_WQT), 2048, 2048, 2048};
            EpiB e{(bf16_t*)(ws + W_QP), 2048};
            SchedGrid s{32, 8, G, c, 0}; gemm_phase(lds, g, s, e);
            for (int ti = c; ti < 128; ti += G) s68_plain(p, ti, W_X1B, W_WQT, nullptr, (bf16_t*)(ws + W_QP), ldsf);
            UCONV(10922, 16384); })
    RUNPH_NB(10, { Gemm g{(const bf16_t*)(ws + W_QP), (const bf16_t*)(ws + W_WKT), 2048, 256, 256};
            EpiF e{(float*)(ws + W_SC), 2048};
            SchedGrid s{32, 8, G, c, 2}; gemm_phase(lds, g, s, e);
            for (int ti = c; ti < 64; ti += G) s9_scores(p, ti); })
    if (p.ph_lo <= 10 && 11 < p.ph_hi) { ++nbar; grid_bar(barw, nbar); }
    RUNPH(11, p9b(p, 0))
    RUNPH(12, p10(p, ldsf))
    if (p.ph_hi > 4096) cg::this_grid().sync();
#ifdef DBG_DUMP
    RUNPH(13, dbg_dump(p))
#endif
}

#ifndef N_LAUNCH_PER_PHASE
#define N_LAUNCH_PER_PHASE 0
#endif

extern "C" void kernel_launch(void* const* d_in, const int* in_sizes, int n_in, void* d_out, int out_size, void* d_ws, size_t ws_size, hipStream_t stream) {
    constexpr int LDS_BYTES = STAGE_BYTES;
    static int grid = 0;
    if (grid == 0) {
        if (n_in != 31 || ws_size < W_END) { fprintf(stderr, "kernel_launch: unexpected n_in %d / ws_size %zu (need %zu)\n", n_in, ws_size, (size_t)W_END); grid = -1; return; }
        int dev = 0, cus = 0, per_cu = 0;
        hipGetDevice(&dev); hipDeviceGetAttribute(&cus, hipDeviceAttributeMultiprocessorCount, dev);
        if (hipFuncSetAttribute((const void*)fwd_kernel, hipFuncAttributeMaxDynamicSharedMemorySize, LDS_BYTES) != hipSuccess) { fprintf(stderr, "hipFuncSetAttribute failed\n"); grid = -1; return; }
        if (hipOccupancyMaxActiveBlocksPerMultiprocessor(&per_cu, (const void*)fwd_kernel, 512, LDS_BYTES) != hipSuccess || per_cu < 1) { fprintf(stderr, "occupancy query failed (%d)\n", per_cu); per_cu = 1; }
        (void)hipGetLastError();
        grid = cus * (per_cu > 1 ? 1 : per_cu);
    }
    if (grid < 0) return;
    Params p{};
    for (int i = 0; i < 31; ++i) p.in[i] = (const float*)d_in[i];
    p.out = (float*)d_out; p.ws = (unsigned char*)d_ws;
#if N_LAUNCH_PER_PHASE
    #ifdef DBG_DUMP
    for (int ph = 0; ph < DBG_LAST; ++ph) { p.ph_lo = ph; p.ph_hi = ph + 1; hipLaunchKernelGGL(fwd_kernel, dim3(grid), dim3(512), LDS_BYTES, stream, p); }
    p.ph_lo = 13; p.ph_hi = 14; hipLaunchKernelGGL(fwd_kernel, dim3(grid), dim3(512), LDS_BYTES, stream, p);
#else
    for (int ph = 0; ph < NPH; ++ph) { p.ph_lo = ph; p.ph_hi = ph + 1; hipLaunchKernelGGL(fwd_kernel, dim3(grid), dim3(512), LDS_BYTES, stream, p); }
#endif
#else
    p.ph_lo = 0; p.ph_hi = NPH;
    (void)hipMemsetAsync((char*)d_ws + W_BAR, 0, 2048, stream);
    void* args[] = {&p};
    hipError_t e = hipLaunchCooperativeKernel((const void*)fwd_kernel, dim3(grid), dim3(512), args, LDS_BYTES, stream);
    if (e != hipSuccess) fprintf(stderr, "cooperative launch failed: %s (grid %d)\n", hipGetErrorString(e), grid);
#endif
}
```
